# Optimizing an MI355X kernel written in HIP

```python
import math
import jax
import jax.numpy as jnp
from jax import lax
import numpy as np

D_MODEL = 1024
BATCH = 8
SEQ = 4096
DEPTH = 2

CHUNK = 64
Q_BLOCK = 128
RMS_EPS = 1e-6
SUBLN_EPS = 1e-5
D_MIX = D_MODEL
D_FF = 4 * D_MODEL
DA_WIDTH = D_MIX // 4
DA_V = 64
DA_HEADS = DA_WIDTH // DA_V
DA_QK = DA_V // 2
MLA_WIDTH = D_MIX // 4
MLA_V = 64
MLA_HEADS = MLA_WIDTH // MLA_V
MLA_NOPE = 64
MLA_ROPE = 32
MLA_Q_LORA = D_MODEL // 4
MLA_KV_LORA = D_MODEL // 8
ROPE_THETA = 10000.0
SSM_WIDTH = D_MIX - DA_WIDTH - MLA_WIDTH
SSM_HEAD_DIM = 64
SSM_HEADS = SSM_WIDTH // SSM_HEAD_DIM
SSM_GROUPS = 2
SSM_STATE = 64
CONV_WIDTH = 4
CONV_CH = SSM_WIDTH + 2 * SSM_GROUPS * SSM_STATE
IN_SIZES = (DA_WIDTH, DA_WIDTH, DA_WIDTH, MLA_Q_LORA, MLA_KV_LORA, MLA_ROPE, SSM_WIDTH, CONV_CH, SSM_HEADS)
D_IN = sum(IN_SIZES)

kernel_name = 'hybrid_chunk_causal_parallel_heads'


def _rmsnorm(t, g, eps=RMS_EPS):
    tf = t.astype(jnp.float32)
    tf = tf * lax.rsqrt(jnp.mean(tf * tf, axis=-1, keepdims=True) + eps)
    return (tf * g.astype(jnp.float32)).astype(t.dtype)


def _rope_tables(positions):
    inv_freq = 1.0 / (ROPE_THETA ** (jnp.arange(0, MLA_ROPE, 2, dtype=jnp.float32) / MLA_ROPE))
    ang = positions.astype(jnp.float32)[..., None] * inv_freq
    return jnp.cos(ang), jnp.sin(ang)


def _apply_rope(t, cos, sin):
    tf = t.astype(jnp.float32)
    t1, t2 = jnp.split(tf, 2, axis=-1)
    return jnp.concatenate([t1 * cos - t2 * sin, t1 * sin + t2 * cos], axis=-1).astype(t.dtype)


def _to_blocks(t):
    b, s = t.shape[0], t.shape[1]
    return jnp.moveaxis(t.reshape((b, s // Q_BLOCK, Q_BLOCK) + t.shape[2:]), 1, 0)


def _from_blocks(o):
    nb, b, qb = o.shape[0], o.shape[1], o.shape[2]
    return jnp.moveaxis(o, 0, 1).reshape((b, nb * qb) + o.shape[3:])


def _chunk_mask(q_start, seq):
    q_chunk = (q_start + jnp.arange(Q_BLOCK)) // CHUNK
    k_chunk = jnp.arange(seq) // CHUNK
    return k_chunk[None, :] <= q_chunk[:, None]


def _masked_softmax(s, mask):
    return jax.nn.softmax(jnp.where(mask, s, -jnp.inf), axis=-1)


def _diff_attention(q, k, v, lam, subln_g, lambda_init):
    b, s, _ = q.shape
    q = q.reshape(b, s, DA_HEADS, 2, DA_QK)
    k = k.reshape(b, s, DA_HEADS, 2, DA_QK)
    v = v.reshape(b, s, DA_HEADS, DA_V)
    k1, k2 = k[..., 0, :], k[..., 1, :]
    scale = DA_QK ** -0.5

    def block(args):
        start, q1b, q2b = args
        mask = _chunk_mask(start, s)
        s1 = jnp.einsum('bqhd,bkhd->bhqk', q1b, k1).astype(jnp.float32) * scale
        s2 = jnp.einsum('bqhd,bkhd->bhqk', q2b, k2).astype(jnp.float32) * scale
        p = _masked_softmax(s1, mask) - lam * _masked_softmax(s2, mask)
        return jnp.einsum('bhqk,bkhe->bqhe', p.astype(v.dtype), v)

    starts = jnp.arange(s // Q_BLOCK) * Q_BLOCK
    o = _from_blocks(lax.map(block, (starts, _to_blocks(q[..., 0, :]), _to_blocks(q[..., 1, :]))))
    o = _rmsnorm(o, subln_g, SUBLN_EPS) * (1.0 - lambda_init)
    return o.reshape(b, s, DA_WIDTH)


def _mla(cq, ckv, kr, cos, sin, q_norm_g, w_uq, kv_norm_g, w_ukv):
    b, s, _ = cq.shape
    q = (_rmsnorm(cq, q_norm_g) @ w_uq).reshape(b, s, MLA_HEADS, MLA_NOPE + MLA_ROPE)
    qn = q[..., :MLA_NOPE]
    qr = _apply_rope(q[..., MLA_NOPE:], cos[:, :, None, :], sin[:, :, None, :])
    kv = (_rmsnorm(ckv, kv_norm_g) @ w_ukv).reshape(b, s, MLA_HEADS, MLA_NOPE + MLA_V)
    kn, v = kv[..., :MLA_NOPE], kv[..., MLA_NOPE:]
    kr = _apply_rope(kr, cos, sin)
    scale = (MLA_NOPE + MLA_ROPE) ** -0.5

    def block(args):
        start, qnb, qrb = args
        sc = (jnp.einsum('bqhd,bkhd->bhqk', qnb, kn)
              + jnp.einsum('bqhr,bkr->bhqk', qrb, kr)).astype(jnp.float32) * scale
        p = _masked_softmax(sc, _chunk_mask(start, s))
        return jnp.einsum('bhqk,bkhe->bqhe', p.astype(v.dtype), v)

    starts = jnp.arange(s // Q_BLOCK) * Q_BLOCK
    o = _from_blocks(lax.map(block, (starts, _to_blocks(qn), _to_blocks(qr))))
    return o.reshape(b, s, MLA_WIDTH)


def _ssd_scan(xs, dt, a, bm, cm):
    b, l, h, p = xs.shape
    n = bm.shape[-1]
    nc = l // CHUNK
    xd = (xs * dt[..., None]).reshape(b, nc, CHUNK, h, p)
    bc = bm.reshape(b, nc, CHUNK, h, n)
    cc = cm.reshape(b, nc, CHUNK, h, n)
    a_cs = jnp.cumsum(jnp.moveaxis((dt * a).reshape(b, nc, CHUNK, h), 3, 1), axis=-1)
    seg = a_cs[..., :, None] - a_cs[..., None, :]
    causal = jnp.tril(jnp.ones((CHUNK, CHUNK), dtype=bool))
    decay_in = jnp.exp(jnp.where(causal, seg, -jnp.inf))
    scores = jnp.einsum('bclhn,bcshn->bhcls', cc, bc) * decay_in
    y_diag = jnp.einsum('bhcls,bcshp->bclhp', scores, xd)
    decay_to_end = jnp.exp(a_cs[..., -1:] - a_cs)
    chunk_states = jnp.einsum('bclhn,bhcl,bclhp->bchpn', bc, decay_to_end, xd)
    chunk_decay = jnp.exp(a_cs[..., -1])

    def step(state, inp):
        st, dec = inp
        return state * dec[..., None, None] + st, state

    init = jnp.zeros((b, h, p, n), jnp.float32)
    _, prev = lax.scan(step, init, (jnp.moveaxis(chunk_states, 1, 0), jnp.moveaxis(chunk_decay, 2, 0)))
    prev = jnp.moveaxis(prev, 0, 1)
    y_off = jnp.einsum('bclhn,bchpn,bhcl->bclhp', cc, prev, jnp.exp(a_cs))
    return (y_diag + y_off).reshape(b, l, h, p)


def _mamba2(z, xbc, dt_raw, conv_w, conv_b, dt_bias, a_log, d_skip, norm_g):
    b, s, _ = z.shape
    xbc = lax.conv_general_dilated(xbc, conv_w[:, None, :].astype(xbc.dtype), (1,), [(CONV_WIDTH - 1, 0)],
                                   dimension_numbers=('NWC', 'WIO', 'NWC'), feature_group_count=CONV_CH)
    xbc = jax.nn.silu(xbc + conv_b)
    xs, bm, cm = jnp.split(xbc.astype(jnp.float32), [SSM_WIDTH, SSM_WIDTH + SSM_GROUPS * SSM_STATE], axis=-1)
    xs = xs.reshape(b, s, SSM_HEADS, SSM_HEAD_DIM)
    rep = SSM_HEADS // SSM_GROUPS
    bm = jnp.repeat(bm.reshape(b, s, SSM_GROUPS, SSM_STATE), rep, axis=2)
    cm = jnp.repeat(cm.reshape(b, s, SSM_GROUPS, SSM_STATE), rep, axis=2)
    dt = jax.nn.softplus(dt_raw.astype(jnp.float32) + dt_bias.astype(jnp.float32))
    a = -jnp.exp(a_log.astype(jnp.float32))
    y = _ssd_scan(xs, dt, a, bm, cm) + xs * d_skip.astype(jnp.float32)[:, None]
    y = y.reshape(b, s, SSM_WIDTH) * jax.nn.silu(z.astype(jnp.float32))
    y = _rmsnorm(y.reshape(b, s, SSM_GROUPS, SSM_WIDTH // SSM_GROUPS), norm_g.reshape(SSM_GROUPS, -1))
    return y.reshape(b, s, SSM_WIDTH).astype(z.dtype)


def _hybrid_mixer(h, cos, sin, layer, w_in, lam_p, subln_g, q_norm_g, w_uq, kv_norm_g, w_ukv,
                  conv_w, conv_b, dt_bias, a_log, d_skip, ssm_norm_g, w_out):
    proj = h @ w_in
    splits = np.cumsum(IN_SIZES)[:-1].tolist()
    a_q, a_k, a_v, b_cq, b_ckv, b_kr, c_z, c_xbc, c_dt = jnp.split(proj, splits, axis=-1)
    lambda_init = 0.8 - 0.6 * math.exp(-0.3 * layer)
    lp = lam_p.astype(jnp.float32)
    lam = jnp.exp(jnp.sum(lp[0] * lp[1])) - jnp.exp(jnp.sum(lp[2] * lp[3])) + lambda_init
    y_a = _diff_attention(a_q, a_k, a_v, lam, subln_g, lambda_init)
    y_b = _mla(b_cq, b_ckv, b_kr, cos, sin, q_norm_g, w_uq, kv_norm_g, w_ukv)
    y_c = _mamba2(c_z, c_xbc, c_dt, conv_w, conv_b, dt_bias, a_log, d_skip, ssm_norm_g)
    return jnp.concatenate([y_a, y_b, y_c], axis=-1) @ w_out


def _sq_relu_mlp(h, w_up, w_down):
    return jnp.square(jax.nn.relu(h @ w_up)) @ w_down


def setup_inputs(seed: int = 0) -> dict:
    key = jax.random.key(seed)
    ks = jax.random.split(key, 24)

    def nrm(k, shape, scale):
        return jax.random.normal(k, shape, jnp.float32) * scale

    x = nrm(ks[0], (BATCH, SEQ, D_MODEL), 1.0)
    c = nrm(ks[1], (BATCH, D_MODEL), 1.0)
    offset = jax.random.randint(ks[2], (BATCH, 1), 0, 4096, dtype=jnp.int32)
    positions = offset + jnp.arange(SEQ, dtype=jnp.int32)[None, :]
    w_ada = nrm(ks[3], (DEPTH, D_MODEL, 6 * D_MODEL), 0.5 * D_MODEL ** -0.5)
    b_ada = nrm(ks[4], (DEPTH, 6 * D_MODEL), 0.02)
    norm_g = 1.0 + nrm(ks[5], (DEPTH, 4, D_MODEL), 0.02)
    w_in = nrm(ks[6], (DEPTH, D_MODEL, D_IN), D_MODEL ** -0.5)
    diff_lambda = nrm(ks[7], (DEPTH, 4, DA_QK), 0.1)
    diff_subln_g = 1.0 + nrm(ks[8], (DEPTH, DA_V), 0.02)
    mla_q_norm_g = 1.0 + nrm(ks[9], (DEPTH, MLA_Q_LORA), 0.02)
    w_uq = nrm(ks[10], (DEPTH, MLA_Q_LORA, MLA_HEADS * (MLA_NOPE + MLA_ROPE)), MLA_Q_LORA ** -0.5)
    mla_kv_norm_g = 1.0 + nrm(ks[11], (DEPTH, MLA_KV_LORA), 0.02)
    w_ukv = nrm(ks[12], (DEPTH, MLA_KV_LORA, MLA_HEADS * (MLA_NOPE + MLA_V)), MLA_KV_LORA ** -0.5)
    conv_w = nrm(ks[13], (DEPTH, CONV_WIDTH, CONV_CH), CONV_WIDTH ** -0.5)
    conv_b = nrm(ks[14], (DEPTH, CONV_CH), 0.02)
    dt0 = jnp.exp(jax.random.uniform(ks[15], (DEPTH, SSM_HEADS), jnp.float32,
                                     math.log(1e-3), math.log(1e-1)))
    dt_bias = dt0 + jnp.log(-jnp.expm1(-dt0))
    a_log = jnp.log(jax.random.uniform(ks[16], (DEPTH, SSM_HEADS), jnp.float32, 1.0, 16.0))
    d_skip = 1.0 + nrm(ks[17], (DEPTH, SSM_HEADS), 0.1)
    ssm_norm_g = 1.0 + nrm(ks[18], (DEPTH, SSM_WIDTH), 0.02)
    w_out = nrm(ks[19], (DEPTH, D_MIX, D_MODEL), D_MIX ** -0.5)
    w_up = nrm(ks[20], (DEPTH, D_MODEL, D_FF), D_MODEL ** -0.5)
    w_down = nrm(ks[21], (DEPTH, D_FF, D_MODEL), D_FF ** -0.5)
    return {'x': x, 'c': c, 'positions': positions, 'w_ada': w_ada, 'b_ada': b_ada, 'norm_g': norm_g,
            'w_in': w_in, 'diff_lambda': diff_lambda, 'diff_subln_g': diff_subln_g,
            'mla_q_norm_g': mla_q_norm_g, 'w_uq': w_uq, 'mla_kv_norm_g': mla_kv_norm_g, 'w_ukv': w_ukv,
            'conv_w': conv_w, 'conv_b': conv_b, 'dt_bias': dt_bias, 'a_log': a_log, 'd_skip': d_skip,
            'ssm_norm_g': ssm_norm_g, 'w_out': w_out, 'w_up': w_up, 'w_down': w_down}


def reference(x, c, positions, w_ada, b_ada, norm_g, w_in, diff_lambda, diff_subln_g,
              mla_q_norm_g, w_uq, mla_kv_norm_g, w_ukv, conv_w, conv_b, dt_bias, a_log, d_skip,
              ssm_norm_g, w_out, w_up, w_down):
    cos, sin = _rope_tables(positions)
    cond = jax.nn.silu(c)
    for l in range(DEPTH):
        mod = (cond @ w_ada[l] + b_ada[l])[:, None, :]
        sh_m, sc_m, g_m, sh_f, sc_f, g_f = jnp.split(mod, 6, axis=-1)
        h = _rmsnorm(x, norm_g[l, 0]) * (1.0 + sc_m) + sh_m
        y = _hybrid_mixer(h, cos, sin, l, w_in[l], diff_lambda[l], diff_subln_g[l],
                          mla_q_norm_g[l], w_uq[l], mla_kv_norm_g[l], w_ukv[l],
                          conv_w[l], conv_b[l], dt_bias[l], a_log[l], d_skip[l], ssm_norm_g[l], w_out[l])
        x = x + g_m * _rmsnorm(y, norm_g[l, 1])
        h = _rmsnorm(x, norm_g[l, 2]) * (1.0 + sc_f) + sh_f
        y = _sq_relu_mlp(h, w_up[l], w_down[l])
        x = x + g_f * _rmsnorm(y, norm_g[l, 3])
    return x
```

```cpp
#include <hip/hip_runtime.h>
#include <cstdint>
#include <cstdio>

typedef unsigned short bf16_t;
typedef short bf16x8 __attribute__((ext_vector_type(8)));
typedef float f32x4 __attribute__((ext_vector_type(4)));

constexpr int NB = 8, SEQ = 4096, DM = 1024, T = NB * SEQ, DEPTH = 2;
constexpr int DIN = 2472, DINP = 2560, DFF = 4096;
constexpr int C_AQ = 0, C_AK = 256, C_AV = 512, C_CQ = 768, C_CKV = 1024, C_KR = 1152, C_Z = 1184, C_XBC = 1696, C_DT = 2464;
constexpr int NCH = SEQ / 64;
constexpr float LOG2E = 1.4426950408889634f;
constexpr float DA_SCALE = 0.17677669529663687f * LOG2E;
constexpr float MLA_SCALE = 0.10206207261596577f * LOG2E;

constexpr size_t MiB = 1u << 20;
constexpr size_t WS_CTL = 0;
constexpr size_t WS_MOD = 1 * MiB;
constexpr size_t WS_COS = 2 * MiB;
constexpr size_t WS_SIN = 4 * MiB;
constexpr size_t WS_DTF = 6 * MiB;
constexpr size_t WS_ACS = 7 * MiB;
constexpr size_t WS_DTV = 8 * MiB;
constexpr size_t WS_W0 = 9 * MiB;
constexpr size_t W_IN = 0, W_OUT = 5 * MiB, W_UP = 7 * MiB, W_DN = 15 * MiB, W_UQ = 23 * MiB, W_UKV = 23 * MiB + 512 * 1024, W_LAYER = 24 * MiB;
constexpr size_t WS_XN = 57 * MiB;
constexpr size_t WS_Y = WS_XN;
constexpr size_t WS_YO = 121 * MiB;
constexpr size_t WS_CS = 121 * MiB;
constexpr size_t WS_YS = 121 * MiB;
constexpr size_t WS_PREV = 185 * MiB;
constexpr size_t WS_R = 249 * MiB;
constexpr size_t WS_H = WS_R;
constexpr size_t WS_PROJ = WS_R;
constexpr size_t WS_QM = WS_R + 160 * MiB;
constexpr size_t WS_KM = WS_R + 184 * MiB;
constexpr size_t WS_VM = WS_R + 208 * MiB;
constexpr size_t WS_XBC = WS_R + 160 * MiB;
constexpr size_t WS_END = 505 * MiB;

__device__ __forceinline__ float bf2f(bf16_t v) { return __uint_as_float((unsigned)v << 16); }
__device__ __forceinline__ bf16_t f2bf(float f) { unsigned u = __float_as_uint(f); return (bf16_t)((u + 0x7fffu + ((u >> 16) & 1u)) >> 16); }
__device__ __forceinline__ float wave_sum(float v) {
#pragma unroll
    for (int o = 1; o < 64; o <<= 1) v += __shfl_xor(v, o);
    return v;
}
__device__ __forceinline__ float silu_f(float v) { return v / (1.f + __expf(-v)); }

__global__ void k_wt(const float* __restrict__ W, int K, int N, int Npad, bf16_t* __restrict__ Wt, int ldk, int row_off, int k_off, const float* __restrict__ g) {
    __shared__ float tile[32][33];
    const int n0 = blockIdx.x * 32, k0 = blockIdx.y * 32, tx = threadIdx.x & 31, ty = threadIdx.x >> 5;
    for (int i = ty; i < 32; i += 8) { const int k = k0 + i, n = n0 + tx; float v = (n < N) ? W[(size_t)k * N + n] : 0.f; if (g) v *= g[k]; tile[i][tx] = v; }
    __syncthreads();
    for (int i = ty; i < 32; i += 8) { const int n = n0 + i, k = k0 + tx; Wt[(size_t)(row_off + n) * ldk + k_off + k] = f2bf(tile[tx][i]); }
}
__global__ void k_zero16(bf16_t* p, size_t n) { size_t i = (size_t)blockIdx.x * blockDim.x + threadIdx.x; if (i < n) p[i] = 0; }

__global__ void k_mod(const float* __restrict__ c, const float* __restrict__ w_ada, const float* __restrict__ b_ada, float* __restrict__ MOD) {
    __shared__ float sc[8 * 1024];
    for (int i = threadIdx.x; i < 8 * 1024; i += blockDim.x) sc[i] = silu_f(c[i]);
    __syncthreads();
    const int gid = blockIdx.x * blockDim.x + threadIdx.x; if (gid >= 2 * 6144) return;
    const int l = gid / 6144, n = gid % 6144;
    float acc[8];
#pragma unroll
    for (int b = 0; b < 8; ++b) acc[b] = 0.f;
    const float* w = w_ada + (size_t)l * 1024 * 6144 + n;
    for (int k = 0; k < 1024; ++k) { const float wv = w[(size_t)k * 6144];
#pragma unroll
        for (int b = 0; b < 8; ++b) acc[b] += sc[b * 1024 + k] * wv; }
#pragma unroll
    for (int b = 0; b < 8; ++b) MOD[(size_t)(l * 8 + b) * 6144 + n] = acc[b] + b_ada[l * 6144 + n];
}
__global__ void k_rope(const int* __restrict__ pos, float* __restrict__ COS, float* __restrict__ SIN) {
    const int gid = blockIdx.x * blockDim.x + threadIdx.x; if (gid >= T * 16) return;
    const int t = gid >> 4, i = gid & 15;
    const float inv = (float)pow(10000.0, -(double)i / 16.0);
    const float ang = (float)pos[t] * inv;
    COS[gid] = (float)cos((double)ang); SIN[gid] = (float)sin((double)ang);
}

__global__ void k_norm_mod(const float* __restrict__ x, const float* __restrict__ g, const float* __restrict__ sh, const float* __restrict__ sc, bf16_t* __restrict__ XN) {
    const int row = blockIdx.x * 4 + (threadIdx.x >> 6), lane = threadIdx.x & 63, b = row / SEQ;
    const f32x4* xr = (const f32x4*)(x + (size_t)row * DM);
    f32x4 v[4]; float ss = 0.f;
#pragma unroll
    for (int j = 0; j < 4; ++j) { v[j] = xr[lane + 64 * j]; ss += v[j].x * v[j].x + v[j].y * v[j].y + v[j].z * v[j].z + v[j].w * v[j].w; }
    const float rstd = 1.0f / sqrtf(wave_sum(ss) * (1.f / DM) + 1e-6f);
#pragma unroll
    for (int j = 0; j < 4; ++j) { const int col = (lane + 64 * j) * 4;
        const f32x4 gv = *(const f32x4*)(g + col), shv = *(const f32x4*)(sh + (size_t)b * 6144 + col), scv = *(const f32x4*)(sc + (size_t)b * 6144 + col);
        bf16_t* o = XN + (size_t)row * DM + col;
        o[0] = f2bf(v[j].x * rstd * gv.x * (1.f + scv.x) + shv.x); o[1] = f2bf(v[j].y * rstd * gv.y * (1.f + scv.y) + shv.y);
        o[2] = f2bf(v[j].z * rstd * gv.z * (1.f + scv.z) + shv.z); o[3] = f2bf(v[j].w * rstd * gv.w * (1.f + scv.w) + shv.w); }
}
__global__ void k_resnorm(const float* xi, const float* __restrict__ yo, const float* __restrict__ gw, const float* __restrict__ gate, float* xo,
                          const float* __restrict__ g2, const float* __restrict__ sh, const float* __restrict__ sc, bf16_t* __restrict__ XN) {
    const int row = blockIdx.x * 4 + (threadIdx.x >> 6), lane = threadIdx.x & 63, b = row / SEQ;
    const f32x4* yr = (const f32x4*)(yo + (size_t)row * DM); const f32x4* xr = (const f32x4*)(xi + (size_t)row * DM);
    f32x4 v[4]; float ss = 0.f;
#pragma unroll
    for (int j = 0; j < 4; ++j) { v[j] = yr[lane + 64 * j]; ss += v[j].x * v[j].x + v[j].y * v[j].y + v[j].z * v[j].z + v[j].w * v[j].w; }
    const float rstd = 1.0f / sqrtf(wave_sum(ss) * (1.f / DM) + 1e-6f);
    float s2 = 0.f;
#pragma unroll
    for (int j = 0; j < 4; ++j) { const int col = (lane + 64 * j) * 4;
        const f32x4 gv = *(const f32x4*)(gw + col), gt = *(const f32x4*)(gate + (size_t)b * 6144 + col), xv = xr[lane + 64 * j];
        v[j].x = xv.x + gt.x * (v[j].x * rstd * gv.x); v[j].y = xv.y + gt.y * (v[j].y * rstd * gv.y); v[j].z = xv.z + gt.z * (v[j].z * rstd * gv.z); v[j].w = xv.w + gt.w * (v[j].w * rstd * gv.w);
        *(f32x4*)(xo + (size_t)row * DM + col) = v[j];
        s2 += v[j].x * v[j].x + v[j].y * v[j].y + v[j].z * v[j].z + v[j].w * v[j].w; }
    if (XN) {
        const float r2 = 1.0f / sqrtf(wave_sum(s2) * (1.f / DM) + 1e-6f);
#pragma unroll
        for (int j = 0; j < 4; ++j) { const int col = (lane + 64 * j) * 4;
            const f32x4 gv = *(const f32x4*)(g2 + col), shv = *(const f32x4*)(sh + (size_t)b * 6144 + col), scv = *(const f32x4*)(sc + (size_t)b * 6144 + col);
            bf16_t* o = XN + (size_t)row * DM + col;
            o[0] = f2bf(v[j].x * r2 * gv.x * (1.f + scv.x) + shv.x); o[1] = f2bf(v[j].y * r2 * gv.y * (1.f + scv.y) + shv.y);
            o[2] = f2bf(v[j].z * r2 * gv.z * (1.f + scv.z) + shv.z); o[3] = f2bf(v[j].w * r2 * gv.w * (1.f + scv.w) + shv.w); }
    }
}

template <int MODE>
__global__ void __launch_bounds__(256) k_gemm_ref(const bf16_t* __restrict__ A, int lda, const bf16_t* __restrict__ Bt, int ldb, int K, bf16_t* __restrict__ O, float* __restrict__ F, int ldc, float* __restrict__ DTF) {
    const int wave = threadIdx.x >> 6, lane = threadIdx.x & 63, r16 = lane & 15, q4 = lane >> 4;
    const int m0 = blockIdx.y * 64 + (wave >> 1) * 32, n0 = blockIdx.x * 64 + (wave & 1) * 32;
    f32x4 acc[2][2];
#pragma unroll
    for (int i = 0; i < 2; ++i)
#pragma unroll
        for (int j = 0; j < 2; ++j) acc[i][j] = (f32x4){0.f, 0.f, 0.f, 0.f};
    const bf16_t* a0 = A + (size_t)(m0 + r16) * lda + q4 * 8; const bf16_t* a1 = a0 + (size_t)16 * lda;
    const bf16_t* b0 = Bt + (size_t)(n0 + r16) * ldb + q4 * 8; const bf16_t* b1 = b0 + (size_t)16 * ldb;
    for (int k = 0; k < K; k += 32) {
        const bf16x8 fa0 = *(const bf16x8*)(a0 + k), fa1 = *(const bf16x8*)(a1 + k), fb0 = *(const bf16x8*)(b0 + k), fb1 = *(const bf16x8*)(b1 + k);
        acc[0][0] = __builtin_amdgcn_mfma_f32_16x16x32_bf16(fa0, fb0, acc[0][0], 0, 0, 0);
        acc[0][1] = __builtin_amdgcn_mfma_f32_16x16x32_bf16(fa0, fb1, acc[0][1], 0, 0, 0);
        acc[1][0] = __builtin_amdgcn_mfma_f32_16x16x32_bf16(fa1, fb0, acc[1][0], 0, 0, 0);
        acc[1][1] = __builtin_amdgcn_mfma_f32_16x16x32_bf16(fa1, fb1, acc[1][1], 0, 0, 0);
    }
#pragma unroll
    for (int i = 0; i < 2; ++i)
#pragma unroll
        for (int j = 0; j < 2; ++j)
#pragma unroll
            for (int r = 0; r < 4; ++r) {
                const int m = m0 + 16 * i + q4 * 4 + r, n = n0 + 16 * j + r16; float v = acc[i][j][r];
                if (MODE == 0) { if (n < 256) v *= DA_SCALE; O[(size_t)m * ldc + n] = f2bf(v); if (n >= C_DT && n < C_DT + 8) DTF[(size_t)m * 8 + (n - C_DT)] = v; }
                else if (MODE == 1) F[(size_t)m * ldc + n] = v;
                else { v = v > 0.f ? v * v : 0.f; O[(size_t)m * ldc + n] = f2bf(v); }
            }
}

__global__ void k_mla_q_ref(const bf16_t* __restrict__ PROJ, const bf16_t* __restrict__ WUQ  , const float* __restrict__ COS, const float* __restrict__ SIN, bf16_t* __restrict__ QM) {
    const int t = blockIdx.x, n = threadIdx.x;
    __shared__ float cq[256]; __shared__ float red[8]; __shared__ float rstd_s;
    if (n < 256) cq[n] = bf2f(PROJ[(size_t)t * DINP + C_CQ + n]);
    __syncthreads();
    if (n < 64) { float s = 0.f; for (int k = n; k < 256; k += 64) s += cq[k] * cq[k]; s = wave_sum(s); if (n == 0) rstd_s = 1.0f / sqrtf(s * (1.f / 256.f) + 1e-6f); }
    __syncthreads();
    const float rstd = rstd_s;
    const int h = n / 96, j = n % 96;
    if (j >= 80) return;
    float d0 = 0.f; { const bf16_t* w = WUQ + (size_t)n * 256; for (int k = 0; k < 256; ++k) d0 += cq[k] * bf2f(w[k]); } d0 *= rstd;
    if (j < 64) { QM[(size_t)t * 384 + n] = f2bf(d0 * MLA_SCALE); return; }
    float d1 = 0.f; { const bf16_t* w = WUQ + (size_t)(n + 16) * 256; for (int k = 0; k < 256; ++k) d1 += cq[k] * bf2f(w[k]); } d1 *= rstd;
    const int i = j - 64; const float cs = COS[(size_t)t * 16 + i], sn = SIN[(size_t)t * 16 + i];
    QM[(size_t)t * 384 + h * 96 + 64 + i] = f2bf((d0 * cs - d1 * sn) * MLA_SCALE);
    QM[(size_t)t * 384 + h * 96 + 80 + i] = f2bf((d0 * sn + d1 * cs) * MLA_SCALE);
}
__global__ void k_mla_kv_ref(const bf16_t* __restrict__ PROJ, const bf16_t* __restrict__ WUKV  , const float* __restrict__ COS, const float* __restrict__ SIN, bf16_t* __restrict__ KM, bf16_t* __restrict__ VM) {
    const int t = blockIdx.x, n = threadIdx.x;
    __shared__ float ck[128]; __shared__ float rstd_s;
    if (n < 128) ck[n] = bf2f(PROJ[(size_t)t * DINP + C_CKV + n]);
    __syncthreads();
    if (n < 64) { float s = ck[n] * ck[n] + ck[n + 64] * ck[n + 64]; s = wave_sum(s); if (n == 0) rstd_s = 1.0f / sqrtf(s * (1.f / 128.f) + 1e-6f); }
    __syncthreads();
    float d = 0.f; { const bf16_t* w = WUKV + (size_t)n * 128; for (int k = 0; k < 128; ++k) d += ck[k] * bf2f(w[k]); } d *= rstd_s;
    const int h = n >> 7, j = n & 127;
    if (j < 64) KM[(size_t)t * 384 + h * 96 + j] = f2bf(d); else VM[(size_t)t * 256 + h * 64 + (j - 64)] = f2bf(d);
    if (n < 16) { const float t1 = bf2f(PROJ[(size_t)t * DINP + C_KR + n]), t2 = bf2f(PROJ[(size_t)t * DINP + C_KR + 16 + n]); const float cs = COS[(size_t)t * 16 + n], sn = SIN[(size_t)t * 16 + n];
        const bf16_t r1 = f2bf(t1 * cs - t2 * sn), r2 = f2bf(t1 * sn + t2 * cs);
        for (int hh = 0; hh < 4; ++hh) { KM[(size_t)t * 384 + hh * 96 + 64 + n] = r1; KM[(size_t)t * 384 + hh * 96 + 80 + n] = r2; } }
}

template <int DQK>
__device__ __forceinline__ void attn_row(const bf16_t* __restrict__ qp, const bf16_t* __restrict__ kbase, int ldk, const bf16_t* __restrict__ vbase, int ldv, int nkeys, float (&o)[32], float& l_out) {
    float q[DQK];
#pragma unroll
    for (int d = 0; d < DQK; ++d) q[d] = bf2f(qp[d]);
    float m = -INFINITY, l = 0.f;
#pragma unroll
    for (int e = 0; e < 32; ++e) o[e] = 0.f;
    for (int j = 0; j < nkeys; ++j) {
        const bf16_t* kp = kbase + (size_t)j * ldk; const bf16_t* vp = vbase + (size_t)j * ldv;
        float s = 0.f;
#pragma unroll
        for (int d = 0; d < DQK; ++d) s += q[d] * bf2f(kp[d]);
        const float mn = fmaxf(m, s), a = exp2f(m - mn), p = exp2f(s - mn);
        l = l * a + p; m = mn;
#pragma unroll
        for (int e = 0; e < 32; ++e) o[e] = o[e] * a + p * bf2f(vp[e]);
    }
    l_out = l;
}
__global__ void __launch_bounds__(128) k_da_ref(const bf16_t* __restrict__ PROJ, bf16_t* __restrict__ Y, const float* __restrict__ lam_p, const float* __restrict__ subln_g, float lambda_init) {
    const int ck = blockIdx.x, h = blockIdx.y, row = threadIdx.x & 63, half = threadIdx.x >> 6;
    const int b = ck / NCH, c = ck % NCH, t = ck * 64 + row, nkeys = (c + 1) * 64;
    const size_t kb = (size_t)b * SEQ * DINP;
    float ls0 = 0.f, ls1 = 0.f;
    for (int i = 0; i < 32; ++i) { ls0 += lam_p[i] * lam_p[32 + i]; ls1 += lam_p[64 + i] * lam_p[96 + i]; }
    const float lam = __expf(ls0) - __expf(ls1) + lambda_init;
    float o1[32], o2[32], l1, l2;
    attn_row<32>(PROJ + (size_t)t * DINP + C_AQ + h * 64, PROJ + kb + C_AK + h * 64, DINP, PROJ + kb + C_AV + h * 64 + half * 32, DINP, nkeys, o1, l1);
    attn_row<32>(PROJ + (size_t)t * DINP + C_AQ + h * 64 + 32, PROJ + kb + C_AK + h * 64 + 32, DINP, PROJ + kb + C_AV + h * 64 + half * 32, DINP, nkeys, o2, l2);
    float ss = 0.f; const float i1 = 1.f / l1, i2 = lam / l2;
#pragma unroll
    for (int e = 0; e < 32; ++e) { o1[e] = o1[e] * i1 - o2[e] * i2; ss += o1[e] * o1[e]; }
    __shared__ float part[128];
    part[threadIdx.x] = ss; __syncthreads();
    const float tot = part[row] + part[64 + row];
    const float rstd = 1.0f / sqrtf(tot * (1.f / 64.f) + 1e-5f) * (1.f - lambda_init);
#pragma unroll
    for (int e = 0; e < 32; ++e) Y[(size_t)t * DM + h * 64 + half * 32 + e] = f2bf(o1[e] * rstd * subln_g[half * 32 + e]);
}
__global__ void __launch_bounds__(128) k_mla_ref(const bf16_t* __restrict__ QM, const bf16_t* __restrict__ KM, const bf16_t* __restrict__ VM, bf16_t* __restrict__ Y) {
    const int ck = blockIdx.x, h = blockIdx.y, row = threadIdx.x & 63, half = threadIdx.x >> 6;
    const int b = ck / NCH, c = ck % NCH, t = ck * 64 + row, nkeys = (c + 1) * 64;
    float o[32], l;
    attn_row<96>(QM + (size_t)t * 384 + h * 96, KM + (size_t)b * SEQ * 384 + h * 96, 384, VM + (size_t)b * SEQ * 256 + h * 64 + half * 32, 256, nkeys, o, l);
    const float il = 1.f / l;
#pragma unroll
    for (int e = 0; e < 32; ++e) Y[(size_t)t * DM + 256 + h * 64 + half * 32 + e] = f2bf(o[e] * il);
}

__global__ void __launch_bounds__(256) k_conv_ref(const bf16_t* __restrict__ PROJ, const float* __restrict__ DTF, const float* __restrict__ conv_w, const float* __restrict__ conv_b,
                                                  const float* __restrict__ dt_bias, const float* __restrict__ a_log, float* __restrict__ XBC, float* __restrict__ DTV, float* __restrict__ ACS) {
    const int ck = blockIdx.x, c = ck % NCH, t0 = ck * 64;
    for (int idx = threadIdx.x; idx < 64 * 768; idx += 256) {
        const int l = idx / 768, ch = idx % 768, t = t0 + l, s = c * 64 + l;
        float acc = conv_b[ch];
#pragma unroll
        for (int w = 0; w < 4; ++w) { const int sp = s - 3 + w; if (sp >= 0) acc += conv_w[w * 768 + ch] * bf2f(PROJ[(size_t)(t - 3 + w) * DINP + C_XBC + ch]); }
        XBC[(size_t)t * 768 + ch] = silu_f(acc);
    }
    if (threadIdx.x < 8) { const int h = threadIdx.x; const float a = -__expf(a_log[h]); float cs = 0.f;
        for (int l = 0; l < 64; ++l) { const float r = DTF[(size_t)(t0 + l) * 8 + h] + dt_bias[h]; const float dt = r > 20.f ? r : log1pf(__expf(r)); cs += dt * a; DTV[(size_t)(t0 + l) * 8 + h] = dt; ACS[(size_t)(t0 + l) * 8 + h] = cs; } }
}
__global__ void __launch_bounds__(256) k_cs_ref(const float* __restrict__ XBC, const float* __restrict__ DTV, const float* __restrict__ ACS, float* __restrict__ CS) {
    const int ck = blockIdx.x, h = blockIdx.y, g = h >> 2, t0 = ck * 64;
    __shared__ float sB[64][64]; __shared__ float sX[64][65];
    for (int idx = threadIdx.x; idx < 4096; idx += 256) { const int l = idx >> 6, j = idx & 63; const size_t r = (size_t)(t0 + l) * 768;
        sB[l][j] = XBC[r + 512 + g * 64 + j];
        sX[l][j] = XBC[r + h * 64 + j] * DTV[(size_t)(t0 + l) * 8 + h] * __expf(ACS[(size_t)(t0 + 63) * 8 + h] - ACS[(size_t)(t0 + l) * 8 + h]); }
    __syncthreads();
    const int p = threadIdx.x >> 2, nb = (threadIdx.x & 3) * 16;
    float acc[16];
#pragma unroll
    for (int i = 0; i < 16; ++i) acc[i] = 0.f;
    for (int l = 0; l < 64; ++l) { const float xv = sX[l][p];
#pragma unroll
        for (int i = 0; i < 16; ++i) acc[i] += xv * sB[l][nb + i]; }
    float* o = CS + ((size_t)(ck * 8 + h) * 64 + p) * 64 + nb;
#pragma unroll
    for (int i = 0; i < 16; ++i) o[i] = acc[i];
}
__global__ void k_scan_ref(const float* __restrict__ CS, const float* __restrict__ ACS, float* __restrict__ PREV) {
    const int gid = blockIdx.x * blockDim.x + threadIdx.x;
    const int e = gid & 4095, h = (gid >> 12) & 7, b = gid >> 15;
    float st = 0.f;
    for (int c = 0; c < NCH; ++c) { const int ck = b * NCH + c; const size_t off = (size_t)(ck * 8 + h) * 4096 + e;
        PREV[off] = st; st = st * __expf(ACS[(size_t)(ck * 64 + 63) * 8 + h]) + CS[off]; }
}
__global__ void __launch_bounds__(256) k_y_ref(const float* __restrict__ XBC, const float* __restrict__ DTV, const float* __restrict__ ACS, const float* __restrict__ PREV, const float* __restrict__ d_skip, float* __restrict__ YS) {
    const int ck = blockIdx.x, h = blockIdx.y, g = h >> 2, t0 = ck * 64;
    __shared__ float sG[64][65]; __shared__ float sX[64][64]; __shared__ float sP[64][65];
    for (int idx = threadIdx.x; idx < 4096; idx += 256) { const int l = idx >> 6, s = idx & 63; float v = 0.f;
        if (s <= l) { const float* cp = XBC + (size_t)(t0 + l) * 768 + 640 + g * 64; const float* bp = XBC + (size_t)(t0 + s) * 768 + 512 + g * 64;
            for (int n = 0; n < 64; ++n) v += cp[n] * bp[n];
            v *= __expf(ACS[(size_t)(t0 + l) * 8 + h] - ACS[(size_t)(t0 + s) * 8 + h]); }
        sG[l][s] = v;
        sX[l][s] = XBC[(size_t)(t0 + l) * 768 + h * 64 + s] * DTV[(size_t)(t0 + l) * 8 + h];
        sP[l][s] = PREV[((size_t)(ck * 8 + h) * 64 + l) * 64 + s]; }
    __syncthreads();
    const int l = threadIdx.x >> 2, pb = (threadIdx.x & 3) * 16;
    float acc[16];
#pragma unroll
    for (int i = 0; i < 16; ++i) acc[i] = 0.f;
    for (int s = 0; s <= l; ++s) { const float gv = sG[l][s];
#pragma unroll
        for (int i = 0; i < 16; ++i) acc[i] += gv * sX[s][pb + i]; }
    const float* cp = XBC + (size_t)(t0 + l) * 768 + 640 + g * 64; const float el = __expf(ACS[(size_t)(t0 + l) * 8 + h]);
    float off[16];
#pragma unroll
    for (int i = 0; i < 16; ++i) off[i] = 0.f;
    for (int n = 0; n < 64; ++n) { const float cv = cp[n];
#pragma unroll
        for (int i = 0; i < 16; ++i) off[i] += cv * sP[pb + i][n]; }
    const float dsk = d_skip[h];
#pragma unroll
    for (int i = 0; i < 16; ++i) YS[(size_t)(t0 + l) * 512 + h * 64 + pb + i] = acc[i] + off[i] * el + XBC[(size_t)(t0 + l) * 768 + h * 64 + pb + i] * dsk;
}
__global__ void k_gate_ref(const float* __restrict__ YS, const bf16_t* __restrict__ PROJ, const float* __restrict__ norm_g, bf16_t* __restrict__ Y) {
    const int wid = blockIdx.x * 4 + (threadIdx.x >> 6), lane = threadIdx.x & 63, t = wid >> 1, g = wid & 1;
    float v[4]; float ss = 0.f;
#pragma unroll
    for (int i = 0; i < 4; ++i) { const int ch = g * 256 + lane * 4 + i; const float z = bf2f(PROJ[(size_t)t * DINP + C_Z + ch]); v[i] = YS[(size_t)t * 512 + ch] * silu_f(z); ss += v[i] * v[i]; }
    const float rstd = 1.0f / sqrtf(wave_sum(ss) * (1.f / 256.f) + 1e-6f);
#pragma unroll
    for (int i = 0; i < 4; ++i) { const int ch = g * 256 + lane * 4 + i; Y[(size_t)t * DM + 512 + ch] = f2bf(v[i] * rstd * norm_g[ch]); }
}

extern "C" void kernel_launch(void* const* d_in, const int* in_sizes, int n_in, void* d_out, int out_size, void* d_ws, size_t ws_size, hipStream_t stream) {
    if (n_in != 22 || out_size != T * DM || ws_size < WS_END) { fprintf(stderr, "kernel_launch: unexpected shapes (n_in %d out %d ws %zu)\n", n_in, out_size, ws_size); return; }
    const float* x = (const float*)d_in[0]; const float* c = (const float*)d_in[1]; const int* pos = (const int*)d_in[2];
    const float* w_ada = (const float*)d_in[3]; const float* b_ada = (const float*)d_in[4]; const float* norm_g = (const float*)d_in[5];
    const float* w_in = (const float*)d_in[6]; const float* diff_lambda = (const float*)d_in[7]; const float* subln_g = (const float*)d_in[8];
    const float* q_norm_g = (const float*)d_in[9]; const float* w_uq = (const float*)d_in[10]; const float* kv_norm_g = (const float*)d_in[11]; const float* w_ukv = (const float*)d_in[12];
    const float* conv_w = (const float*)d_in[13]; const float* conv_b = (const float*)d_in[14]; const float* dt_bias = (const float*)d_in[15]; const float* a_log = (const float*)d_in[16];
    const float* d_skip = (const float*)d_in[17]; const float* ssm_norm_g = (const float*)d_in[18]; const float* w_out = (const float*)d_in[19]; const float* w_up = (const float*)d_in[20]; const float* w_down = (const float*)d_in[21];
    char* ws = (char*)d_ws; float* out = (float*)d_out;
    float* MOD = (float*)(ws + WS_MOD); float* COS = (float*)(ws + WS_COS); float* SIN = (float*)(ws + WS_SIN); float* DTF = (float*)(ws + WS_DTF); float* ACS = (float*)(ws + WS_ACS); float* DTV = (float*)(ws + WS_DTV);
    bf16_t* XN = (bf16_t*)(ws + WS_XN); bf16_t* Y = (bf16_t*)(ws + WS_Y); float* YO = (float*)(ws + WS_YO);
    bf16_t* PROJ = (bf16_t*)(ws + WS_PROJ); bf16_t* QM = (bf16_t*)(ws + WS_QM); bf16_t* KM = (bf16_t*)(ws + WS_KM); bf16_t* VM = (bf16_t*)(ws + WS_VM);
    bf16_t* H = (bf16_t*)(ws + WS_H); float* XBC = (float*)(ws + WS_XBC); float* CS = (float*)(ws + WS_CS); float* PREV = (float*)(ws + WS_PREV); float* YS = (float*)(ws + WS_YS);
    for (int l = 0; l < DEPTH; ++l) {
        char* wl = ws + WS_W0 + (size_t)l * W_LAYER;
        hipLaunchKernelGGL(k_wt, dim3(DINP / 32, DM / 32), dim3(256), 0, stream, w_in + (size_t)l * DM * DIN, DM, DIN, DINP, (bf16_t*)(wl + W_IN), DM, 0, 0, (const float*)nullptr);
        hipLaunchKernelGGL(k_wt, dim3(DM / 32, DM / 32), dim3(256), 0, stream, w_out + (size_t)l * DM * DM, DM, DM, DM, (bf16_t*)(wl + W_OUT), DM, 0, 0, (const float*)nullptr);
        hipLaunchKernelGGL(k_wt, dim3(DFF / 32, DM / 32), dim3(256), 0, stream, w_up + (size_t)l * DM * DFF, DM, DFF, DFF, (bf16_t*)(wl + W_UP), DM, 0, 0, (const float*)nullptr);
        hipLaunchKernelGGL(k_wt, dim3(DM / 32, DFF / 32), dim3(256), 0, stream, w_down + (size_t)l * DFF * DM, DFF, DM, DM, (bf16_t*)(wl + W_DN), DFF, 0, 0, (const float*)nullptr);
        hipLaunchKernelGGL(k_wt, dim3(384 / 32, 256 / 32), dim3(256), 0, stream, w_uq + (size_t)l * 256 * 384, 256, 384, 384, (bf16_t*)(wl + W_UQ), 256, 0, 0, q_norm_g + l * 256);
        hipLaunchKernelGGL(k_wt, dim3(512 / 32, 128 / 32), dim3(256), 0, stream, w_ukv + (size_t)l * 128 * 512, 128, 512, 512, (bf16_t*)(wl + W_UKV), 128, 0, 0, kv_norm_g + l * 128);
    }
    hipLaunchKernelGGL(k_mod, dim3(2 * 6144 / 256), dim3(256), 0, stream, c, w_ada, b_ada, MOD);
    hipLaunchKernelGGL(k_rope, dim3(T * 16 / 256), dim3(256), 0, stream, pos, COS, SIN);
    hipLaunchKernelGGL(k_norm_mod, dim3(T / 4), dim3(256), 0, stream, x, norm_g, MOD + 0, MOD + 1024, XN);
    for (int l = 0; l < DEPTH; ++l) {
        char* wl = ws + WS_W0 + (size_t)l * W_LAYER; const float* mod = MOD + (size_t)l * 8 * 6144;
        const float lambda_init = (l == 0) ? 0.2f : (float)(0.8 - 0.6 * 0.7408182206817179);
        const float* xin = (l == 0) ? x : out;
        hipLaunchKernelGGL(k_gemm_ref<0>, dim3(DINP / 64, T / 64), dim3(256), 0, stream, XN, DM, (const bf16_t*)(wl + W_IN), DM, DM, PROJ, (float*)nullptr, DINP, DTF);
        hipLaunchKernelGGL(k_mla_q_ref, dim3(T), dim3(384), 0, stream, PROJ, (const bf16_t*)(wl + W_UQ), COS, SIN, QM);
        hipLaunchKernelGGL(k_mla_kv_ref, dim3(T), dim3(512), 0, stream, PROJ, (const bf16_t*)(wl + W_UKV), COS, SIN, KM, VM);
        hipLaunchKernelGGL(k_da_ref, dim3(T / 64, 4), dim3(128), 0, stream, PROJ, Y, diff_lambda + l * 128, subln_g + l * 64, lambda_init);
        hipLaunchKernelGGL(k_mla_ref, dim3(T / 64, 4), dim3(128), 0, stream, QM, KM, VM, Y);
        hipLaunchKernelGGL(k_conv_ref, dim3(T / 64), dim3(256), 0, stream, PROJ, DTF, conv_w + (size_t)l * 4 * 768, conv_b + l * 768, dt_bias + l * 8, a_log + l * 8, XBC, DTV, ACS);
        hipLaunchKernelGGL(k_cs_ref, dim3(T / 64, 8), dim3(256), 0, stream, XBC, DTV, ACS, CS);
        hipLaunchKernelGGL(k_scan_ref, dim3(NB * 8 * 4096 / 256), dim3(256), 0, stream, CS, ACS, PREV);
        hipLaunchKernelGGL(k_y_ref, dim3(T / 64, 8), dim3(256), 0, stream, XBC, DTV, ACS, PREV, d_skip + l * 8, YS);
        hipLaunchKernelGGL(k_gate_ref, dim3(T * 2 / 4), dim3(256), 0, stream, YS, PROJ, ssm_norm_g + l * 512, Y);
        hipLaunchKernelGGL(k_gemm_ref<1>, dim3(DM / 64, T / 64), dim3(256), 0, stream, Y, DM, (const bf16_t*)(wl + W_OUT), DM, DM, (bf16_t*)nullptr, YO, DM, (float*)nullptr);
        hipLaunchKernelGGL(k_resnorm, dim3(T / 4), dim3(256), 0, stream, xin, YO, norm_g + (l * 4 + 1) * DM, mod + 2048, out, norm_g + (l * 4 + 2) * DM, mod + 3072, mod + 4096, XN);
        hipLaunchKernelGGL(k_gemm_ref<2>, dim3(DFF / 64, T / 64), dim3(256), 0, stream, XN, DM, (const bf16_t*)(wl + W_UP), DM, DM, H, (float*)nullptr, DFF, (float*)nullptr);
        hipLaunchKernelGGL(k_gemm_ref<1>, dim3(DM / 64, T / 64), dim3(256), 0, stream, H, DFF, (const bf16_t*)(wl + W_DN), DFF, DFF, (bf16_t*)nullptr, YO, DM, (float*)nullptr);
        if (l + 1 < DEPTH) { const float* modn = MOD + (size_t)(l + 1) * 8 * 6144;
            hipLaunchKernelGGL(k_resnorm, dim3(T / 4), dim3(256), 0, stream, out, YO, norm_g + (l * 4 + 3) * DM, mod + 5120, out, norm_g + ((l + 1) * 4 + 0) * DM, modn + 0, modn + 1024, XN);
        } else {
            hipLaunchKernelGGL(k_resnorm, dim3(T / 4), dim3(256), 0, stream, out, YO, norm_g + (l * 4 + 3) * DM, mod + 5120, out, (const float*)nullptr, (const float*)nullptr, (const float*)nullptr, (bf16_t*)nullptr);
        }
    }
}
```

```cpp
#include <hip/hip_runtime.h>
#include <cstdint>
#include <cstdio>

typedef unsigned short bf16_t;
typedef short bf16x8 __attribute__((ext_vector_type(8)));
typedef float f32x4 __attribute__((ext_vector_type(4)));

constexpr int NB = 8, SEQ = 4096, DM = 1024, T = NB * SEQ, DEPTH = 2;
constexpr int DIN = 2472, DINP = 2560, DFF = 4096;
constexpr int C_AQ = 0, C_AK = 256, C_AV = 512, C_CQ = 768, C_CKV = 1024, C_KR = 1152, C_Z = 1184, C_XBC = 1696, C_DT = 2464;
constexpr int NCH = SEQ / 64;
constexpr float LOG2E = 1.4426950408889634f;
constexpr float DA_SCALE = 0.17677669529663687f * LOG2E;
constexpr float MLA_SCALE = 0.10206207261596577f * LOG2E;

constexpr size_t MiB = 1u << 20;
constexpr size_t WS_CTL = 0;
constexpr size_t WS_MOD = 1 * MiB;
constexpr size_t WS_COS = 2 * MiB;
constexpr size_t WS_SIN = 4 * MiB;
constexpr size_t WS_DTF = 6 * MiB;
constexpr size_t WS_ACS = 7 * MiB;
constexpr size_t WS_DTV = 8 * MiB;
constexpr size_t WS_W0 = 9 * MiB;
constexpr size_t W_IN = 0, W_OUT = 5 * MiB, W_UP = 7 * MiB, W_DN = 15 * MiB, W_UQ = 23 * MiB, W_UKV = 23 * MiB + 512 * 1024, W_LAYER = 24 * MiB;
constexpr size_t WS_XN = 57 * MiB;
constexpr size_t WS_Y = WS_XN;
constexpr size_t WS_YO = 121 * MiB;
constexpr size_t WS_CS = 121 * MiB;
constexpr size_t WS_YS = 121 * MiB;
constexpr size_t WS_PREV = 185 * MiB;
constexpr size_t WS_R = 249 * MiB;
constexpr size_t WS_H = WS_R;
constexpr size_t WS_PROJ = WS_R;
constexpr size_t WS_QM = WS_R + 160 * MiB;
constexpr size_t WS_KM = WS_R + 184 * MiB;
constexpr size_t WS_VM = WS_R + 208 * MiB;
constexpr size_t WS_XBC = WS_R + 160 * MiB;
constexpr size_t WS_END = 505 * MiB;

__device__ __forceinline__ float bf2f(bf16_t v) { return __uint_as_float((unsigned)v << 16); }
__device__ __forceinline__ bf16_t f2bf(float f) { unsigned u = __float_as_uint(f); return (bf16_t)((u + 0x7fffu + ((u >> 16) & 1u)) >> 16); }
__device__ __forceinline__ float wave_sum(float v) {
#pragma unroll
    for (int o = 1; o < 64; o <<= 1) v += __shfl_xor(v, o);
    return v;
}
__device__ __forceinline__ float silu_f(float v) { return v / (1.f + __expf(-v)); }

__global__ void k_wt(const float* __restrict__ W, int K, int N, int Npad, bf16_t* __restrict__ Wt, int ldk, int row_off, int k_off, const float* __restrict__ g) {
    __shared__ float tile[32][33];
    const int n0 = blockIdx.x * 32, k0 = blockIdx.y * 32, tx = threadIdx.x & 31, ty = threadIdx.x >> 5;
    for (int i = ty; i < 32; i += 8) { const int k = k0 + i, n = n0 + tx; float v = (n < N) ? W[(size_t)k * N + n] : 0.f; if (g) v *= g[k]; tile[i][tx] = v; }
    __syncthreads();
    for (int i = ty; i < 32; i += 8) { const int n = n0 + i, k = k0 + tx; Wt[(size_t)(row_off + n) * ldk + k_off + k] = f2bf(tile[tx][i]); }
}
__global__ void k_zero16(bf16_t* p, size_t n) { size_t i = (size_t)blockIdx.x * blockDim.x + threadIdx.x; if (i < n) p[i] = 0; }

__global__ void k_mod(const float* __restrict__ c, const float* __restrict__ w_ada, const float* __restrict__ b_ada, float* __restrict__ MOD) {
    __shared__ float sc[8 * 1024];
    for (int i = threadIdx.x; i < 8 * 1024; i += blockDim.x) sc[i] = silu_f(c[i]);
    __syncthreads();
    const int gid = blockIdx.x * blockDim.x + threadIdx.x; if (gid >= 2 * 6144) return;
    const int l = gid / 6144, n = gid % 6144;
    float acc[8];
#pragma unroll
    for (int b = 0; b < 8; ++b) acc[b] = 0.f;
    const float* w = w_ada + (size_t)l * 1024 * 6144 + n;
    for (int k = 0; k < 1024; ++k) { const float wv = w[(size_t)k * 6144];
#pragma unroll
        for (int b = 0; b < 8; ++b) acc[b] += sc[b * 1024 + k] * wv; }
#pragma unroll
    for (int b = 0; b < 8; ++b) MOD[(size_t)(l * 8 + b) * 6144 + n] = acc[b] + b_ada[l * 6144 + n];
}
__global__ void k_rope(const int* __restrict__ pos, float* __restrict__ COS, float* __restrict__ SIN) {
    const int gid = blockIdx.x * blockDim.x + threadIdx.x; if (gid >= T * 16) return;
    const int t = gid >> 4, i = gid & 15;
    const float inv = (float)pow(10000.0, -(double)i / 16.0);
    const float ang = (float)pos[t] * inv;
    COS[gid] = (float)cos((double)ang); SIN[gid] = (float)sin((double)ang);
}

__global__ void k_norm_mod(const float* __restrict__ x, const float* __restrict__ g, const float* __restrict__ sh, const float* __restrict__ sc, bf16_t* __restrict__ XN) {
    const int row = blockIdx.x * 4 + (threadIdx.x >> 6), lane = threadIdx.x & 63, b = row / SEQ;
    const f32x4* xr = (const f32x4*)(x + (size_t)row * DM);
    f32x4 v[4]; float ss = 0.f;
#pragma unroll
    for (int j = 0; j < 4; ++j) { v[j] = xr[lane + 64 * j]; ss += v[j].x * v[j].x + v[j].y * v[j].y + v[j].z * v[j].z + v[j].w * v[j].w; }
    const float rstd = 1.0f / sqrtf(wave_sum(ss) * (1.f / DM) + 1e-6f);
#pragma unroll
    for (int j = 0; j < 4; ++j) { const int col = (lane + 64 * j) * 4;
        const f32x4 gv = *(const f32x4*)(g + col), shv = *(const f32x4*)(sh + (size_t)b * 6144 + col), scv = *(const f32x4*)(sc + (size_t)b * 6144 + col);
        bf16_t* o = XN + (size_t)row * DM + col;
        o[0] = f2bf(v[j].x * rstd * gv.x * (1.f + scv.x) + shv.x); o[1] = f2bf(v[j].y * rstd * gv.y * (1.f + scv.y) + shv.y);
        o[2] = f2bf(v[j].z * rstd * gv.z * (1.f + scv.z) + shv.z); o[3] = f2bf(v[j].w * rstd * gv.w * (1.f + scv.w) + shv.w); }
}
__global__ void k_resnorm(const float* xi, const float* __restrict__ yo, const float* __restrict__ gw, const float* __restrict__ gate, float* xo,
                          const float* __restrict__ g2, const float* __restrict__ sh, const float* __restrict__ sc, bf16_t* __restrict__ XN) {
    const int row = blockIdx.x * 4 + (threadIdx.x >> 6), lane = threadIdx.x & 63, b = row / SEQ;
    const f32x4* yr = (const f32x4*)(yo + (size_t)row * DM); const f32x4* xr = (const f32x4*)(xi + (size_t)row * DM);
    f32x4 v[4]; float ss = 0.f;
#pragma unroll
    for (int j = 0; j < 4; ++j) { v[j] = yr[lane + 64 * j]; ss += v[j].x * v[j].x + v[j].y * v[j].y + v[j].z * v[j].z + v[j].w * v[j].w; }
    const float rstd = 1.0f / sqrtf(wave_sum(ss) * (1.f / DM) + 1e-6f);
    float s2 = 0.f;
#pragma unroll
    for (int j = 0; j < 4; ++j) { const int col = (lane + 64 * j) * 4;
        const f32x4 gv = *(const f32x4*)(gw + col), gt = *(const f32x4*)(gate + (size_t)b * 6144 + col), xv = xr[lane + 64 * j];
        v[j].x = xv.x + gt.x * (v[j].x * rstd * gv.x); v[j].y = xv.y + gt.y * (v[j].y * rstd * gv.y); v[j].z = xv.z + gt.z * (v[j].z * rstd * gv.z); v[j].w = xv.w + gt.w * (v[j].w * rstd * gv.w);
        *(f32x4*)(xo + (size_t)row * DM + col) = v[j];
        s2 += v[j].x * v[j].x + v[j].y * v[j].y + v[j].z * v[j].z + v[j].w * v[j].w; }
    if (XN) {
        const float r2 = 1.0f / sqrtf(wave_sum(s2) * (1.f / DM) + 1e-6f);
#pragma unroll
        for (int j = 0; j < 4; ++j) { const int col = (lane + 64 * j) * 4;
            const f32x4 gv = *(const f32x4*)(g2 + col), shv = *(const f32x4*)(sh + (size_t)b * 6144 + col), scv = *(const f32x4*)(sc + (size_t)b * 6144 + col);
            bf16_t* o = XN + (size_t)row * DM + col;
            o[0] = f2bf(v[j].x * r2 * gv.x * (1.f + scv.x) + shv.x); o[1] = f2bf(v[j].y * r2 * gv.y * (1.f + scv.y) + shv.y);
            o[2] = f2bf(v[j].z * r2 * gv.z * (1.f + scv.z) + shv.z); o[3] = f2bf(v[j].w * r2 * gv.w * (1.f + scv.w) + shv.w); }
    }
}

template <int MODE>
__global__ void __launch_bounds__(256) k_gemm_ref(const bf16_t* __restrict__ A, int lda, const bf16_t* __restrict__ Bt, int ldb, int K, bf16_t* __restrict__ O, float* __restrict__ F, int ldc, float* __restrict__ DTF) {
    const int wave = threadIdx.x >> 6, lane = threadIdx.x & 63, r16 = lane & 15, q4 = lane >> 4;
    const int m0 = blockIdx.y * 64 + (wave >> 1) * 32, n0 = blockIdx.x * 64 + (wave & 1) * 32;
    f32x4 acc[2][2];
#pragma unroll
    for (int i = 0; i < 2; ++i)
#pragma unroll
        for (int j = 0; j < 2; ++j) acc[i][j] = (f32x4){0.f, 0.f, 0.f, 0.f};
    const bf16_t* a0 = A + (size_t)(m0 + r16) * lda + q4 * 8; const bf16_t* a1 = a0 + (size_t)16 * lda;
    const bf16_t* b0 = Bt + (size_t)(n0 + r16) * ldb + q4 * 8; const bf16_t* b1 = b0 + (size_t)16 * ldb;
    for (int k = 0; k < K; k += 32) {
        const bf16x8 fa0 = *(const bf16x8*)(a0 + k), fa1 = *(const bf16x8*)(a1 + k), fb0 = *(const bf16x8*)(b0 + k), fb1 = *(const bf16x8*)(b1 + k);
        acc[0][0] = __builtin_amdgcn_mfma_f32_16x16x32_bf16(fa0, fb0, acc[0][0], 0, 0, 0);
        acc[0][1] = __builtin_amdgcn_mfma_f32_16x16x32_bf16(fa0, fb1, acc[0][1], 0, 0, 0);
        acc[1][0] = __builtin_amdgcn_mfma_f32_16x16x32_bf16(fa1, fb0, acc[1][0], 0, 0, 0);
        acc[1][1] = __builtin_amdgcn_mfma_f32_16x16x32_bf16(fa1, fb1, acc[1][1], 0, 0, 0);
    }
#pragma unroll
    for (int i = 0; i < 2; ++i)
#pragma unroll
        for (int j = 0; j < 2; ++j)
#pragma unroll
            for (int r = 0; r < 4; ++r) {
                const int m = m0 + 16 * i + q4 * 4 + r, n = n0 + 16 * j + r16; float v = acc[i][j][r];
                if (MODE == 0) { if (n < 256) v *= DA_SCALE; O[(size_t)m * ldc + n] = f2bf(v); if (n >= C_DT && n < C_DT + 8) DTF[(size_t)m * 8 + (n - C_DT)] = v; }
                else if (MODE == 1) F[(size_t)m * ldc + n] = v;
                else { v = v > 0.f ? v * v : 0.f; O[(size_t)m * ldc + n] = f2bf(v); }
            }
}

__global__ void k_mla_q_ref(const bf16_t* __restrict__ PROJ, const bf16_t* __restrict__ WUQ  , const float* __restrict__ COS, const float* __restrict__ SIN, bf16_t* __restrict__ QM) {
    const int t = blockIdx.x, n = threadIdx.x;
    __shared__ float cq[256]; __shared__ float red[8]; __shared__ float rstd_s;
    if (n < 256) cq[n] = bf2f(PROJ[(size_t)t * DINP + C_CQ + n]);
    __syncthreads();
    if (n < 64) { float s = 0.f; for (int k = n; k < 256; k += 64) s += cq[k] * cq[k]; s = wave_sum(s); if (n == 0) rstd_s = 1.0f / sqrtf(s * (1.f / 256.f) + 1e-6f); }
    __syncthreads();
    const float rstd = rstd_s;
    const int h = n / 96, j = n % 96;
    if (j >= 80) return;
    float d0 = 0.f; { const bf16_t* w = WUQ + (size_t)n * 256; for (int k = 0; k < 256; ++k) d0 += cq[k] * bf2f(w[k]); } d0 *= rstd;
    if (j < 64) { QM[(size_t)t * 384 + n] = f2bf(d0 * MLA_SCALE); return; }
    float d1 = 0.f; { const bf16_t* w = WUQ + (size_t)(n + 16) * 256; for (int k = 0; k < 256; ++k) d1 += cq[k] * bf2f(w[k]); } d1 *= rstd;
    const int i = j - 64; const float cs = COS[(size_t)t * 16 + i], sn = SIN[(size_t)t * 16 + i];
    QM[(size_t)t * 384 + h * 96 + 64 + i] = f2bf((d0 * cs - d1 * sn) * MLA_SCALE);
    QM[(size_t)t * 384 + h * 96 + 80 + i] = f2bf((d0 * sn + d1 * cs) * MLA_SCALE);
}
__global__ void k_mla_kv_ref(const bf16_t* __restrict__ PROJ, const bf16_t* __restrict__ WUKV  , const float* __restrict__ COS, const float* __restrict__ SIN, bf16_t* __restrict__ KM, bf16_t* __restrict__ VM) {
    const int t = blockIdx.x, n = threadIdx.x;
    __shared__ float ck[128]; __shared__ float rstd_s;
    if (n < 128) ck[n] = bf2f(PROJ[(size_t)t * DINP + C_CKV + n]);
    __syncthreads();
    if (n < 64) { float s = ck[n] * ck[n] + ck[n + 64] * ck[n + 64]; s = wave_sum(s); if (n == 0) rstd_s = 1.0f / sqrtf(s * (1.f / 128.f) + 1e-6f); }
    __syncthreads();
    float d = 0.f; { const bf16_t* w = WUKV + (size_t)n * 128; for (int k = 0; k < 128; ++k) d += ck[k] * bf2f(w[k]); } d *= rstd_s;
    const int h = n >> 7, j = n & 127;
    if (j < 64) KM[(size_t)t * 384 + h * 96 + j] = f2bf(d); else VM[(size_t)t * 256 + h * 64 + (j - 64)] = f2bf(d);
    if (n < 16) { const float t1 = bf2f(PROJ[(size_t)t * DINP + C_KR + n]), t2 = bf2f(PROJ[(size_t)t * DINP + C_KR + 16 + n]); const float cs = COS[(size_t)t * 16 + n], sn = SIN[(size_t)t * 16 + n];
        const bf16_t r1 = f2bf(t1 * cs - t2 * sn), r2 = f2bf(t1 * sn + t2 * cs);
        for (int hh = 0; hh < 4; ++hh) { KM[(size_t)t * 384 + hh * 96 + 64 + n] = r1; KM[(size_t)t * 384 + hh * 96 + 80 + n] = r2; } }
}

template <int DQK>
__device__ __forceinline__ void attn_row(const bf16_t* __restrict__ qp, const bf16_t* __restrict__ kbase, int ldk, const bf16_t* __restrict__ vbase, int ldv, int nkeys, float (&o)[32], float& l_out) {
    float q[DQK];
#pragma unroll
    for (int d = 0; d < DQK; ++d) q[d] = bf2f(qp[d]);
    float m = -INFINITY, l = 0.f;
#pragma unroll
    for (int e = 0; e < 32; ++e) o[e] = 0.f;
    for (int j = 0; j < nkeys; ++j) {
        const bf16_t* kp = kbase + (size_t)j * ldk; const bf16_t* vp = vbase + (size_t)j * ldv;
        float s = 0.f;
#pragma unroll
        for (int d = 0; d < DQK; ++d) s += q[d] * bf2f(kp[d]);
        const float mn = fmaxf(m, s), a = exp2f(m - mn), p = exp2f(s - mn);
        l = l * a + p; m = mn;
#pragma unroll
        for (int e = 0; e < 32; ++e) o[e] = o[e] * a + p * bf2f(vp[e]);
    }
    l_out = l;
}
__global__ void __launch_bounds__(128) k_da_ref(const bf16_t* __restrict__ PROJ, bf16_t* __restrict__ Y, const float* __restrict__ lam_p, const float* __restrict__ subln_g, float lambda_init) {
    const int ck = blockIdx.x, h = blockIdx.y, row = threadIdx.x & 63, half = threadIdx.x >> 6;
    const int b = ck / NCH, c = ck % NCH, t = ck * 64 + row, nkeys = (c + 1) * 64;
    const size_t kb = (size_t)b * SEQ * DINP;
    float ls0 = 0.f, ls1 = 0.f;
    for (int i = 0; i < 32; ++i) { ls0 += lam_p[i] * lam_p[32 + i]; ls1 += lam_p[64 + i] * lam_p[96 + i]; }
    const float lam = __expf(ls0) - __expf(ls1) + lambda_init;
    float o1[32], o2[32], l1, l2;
    attn_row<32>(PROJ + (size_t)t * DINP + C_AQ + h * 64, PROJ + kb + C_AK + h * 64, DINP, PROJ + kb + C_AV + h * 64 + half * 32, DINP, nkeys, o1, l1);
    attn_row<32>(PROJ + (size_t)t * DINP + C_AQ + h * 64 + 32, PROJ + kb + C_AK + h * 64 + 32, DINP, PROJ + kb + C_AV + h * 64 + half * 32, DINP, nkeys, o2, l2);
    float ss = 0.f; const float i1 = 1.f / l1, i2 = lam / l2;
#pragma unroll
    for (int e = 0; e < 32; ++e) { o1[e] = o1[e] * i1 - o2[e] * i2; ss += o1[e] * o1[e]; }
    __shared__ float part[128];
    part[threadIdx.x] = ss; __syncthreads();
    const float tot = part[row] + part[64 + row];
    const float rstd = 1.0f / sqrtf(tot * (1.f / 64.f) + 1e-5f) * (1.f - lambda_init);
#pragma unroll
    for (int e = 0; e < 32; ++e) Y[(size_t)t * DM + h * 64 + half * 32 + e] = f2bf(o1[e] * rstd * subln_g[half * 32 + e]);
}
__global__ void __launch_bounds__(128) k_mla_ref(const bf16_t* __restrict__ QM, const bf16_t* __restrict__ KM, const bf16_t* __restrict__ VM, bf16_t* __restrict__ Y) {
    const int ck = blockIdx.x, h = blockIdx.y, row = threadIdx.x & 63, half = threadIdx.x >> 6;
    const int b = ck / NCH, c = ck % NCH, t = ck * 64 + row, nkeys = (c + 1) * 64;
    float o[32], l;
    attn_row<96>(QM + (size_t)t * 384 + h * 96, KM + (size_t)b * SEQ * 384 + h * 96, 384, VM + (size_t)b * SEQ * 256 + h * 64 + half * 32, 256, nkeys, o, l);
    const float il = 1.f / l;
#pragma unroll
    for (int e = 0; e < 32; ++e) Y[(size_t)t * DM + 256 + h * 64 + half * 32 + e] = f2bf(o[e] * il);
}

__global__ void __launch_bounds__(256) k_conv_ref(const bf16_t* __restrict__ PROJ, const float* __restrict__ DTF, const float* __restrict__ conv_w, const float* __restrict__ conv_b,
                                                  const float* __restrict__ dt_bias, const float* __restrict__ a_log, float* __restrict__ XBC, float* __restrict__ DTV, float* __restrict__ ACS) {
    const int ck = blockIdx.x, c = ck % NCH, t0 = ck * 64;
    for (int idx = threadIdx.x; idx < 64 * 768; idx += 256) {
        const int l = idx / 768, ch = idx % 768, t = t0 + l, s = c * 64 + l;
        float acc = conv_b[ch];
#pragma unroll
        for (int w = 0; w < 4; ++w) { const int sp = s - 3 + w; if (sp >= 0) acc += conv_w[w * 768 + ch] * bf2f(PROJ[(size_t)(t - 3 + w) * DINP + C_XBC + ch]); }
        XBC[(size_t)t * 768 + ch] = silu_f(acc);
    }
    if (threadIdx.x < 8) { const int h = threadIdx.x; const float a = -__expf(a_log[h]); float cs = 0.f;
        for (int l = 0; l < 64; ++l) { const float r = DTF[(size_t)(t0 + l) * 8 + h] + dt_bias[h]; const float dt = r > 20.f ? r : log1pf(__expf(r)); cs += dt * a; DTV[(size_t)(t0 + l) * 8 + h] = dt; ACS[(size_t)(t0 + l) * 8 + h] = cs; } }
}
__global__ void __launch_bounds__(256) k_cs_ref(const float* __restrict__ XBC, const float* __restrict__ DTV, const float* __restrict__ ACS, float* __restrict__ CS) {
    const int ck = blockIdx.x, h = blockIdx.y, g = h >> 2, t0 = ck * 64;
    __shared__ float sB[64][64]; __shared__ float sX[64][65];
    for (int idx = threadIdx.x; idx < 4096; idx += 256) { const int l = idx >> 6, j = idx & 63; const size_t r = (size_t)(t0 + l) * 768;
        sB[l][j] = XBC[r + 512 + g * 64 + j];
        sX[l][j] = XBC[r + h * 64 + j] * DTV[(size_t)(t0 + l) * 8 + h] * __expf(ACS[(size_t)(t0 + 63) * 8 + h] - ACS[(size_t)(t0 + l) * 8 + h]); }
    __syncthreads();
    const int p = threadIdx.x >> 2, nb = (threadIdx.x & 3) * 16;
    float acc[16];
#pragma unroll
    for (int i = 0; i < 16; ++i) acc[i] = 0.f;
    for (int l = 0; l < 64; ++l) { const float xv = sX[l][p];
#pragma unroll
        for (int i = 0; i < 16; ++i) acc[i] += xv * sB[l][nb + i]; }
    float* o = CS + ((size_t)(ck * 8 + h) * 64 + p) * 64 + nb;
#pragma unroll
    for (int i = 0; i < 16; ++i) o[i] = acc[i];
}
__global__ void k_scan_ref(const float* __restrict__ CS, const float* __restrict__ ACS, float* __restrict__ PREV) {
    const int gid = blockIdx.x * blockDim.x + threadIdx.x;
    const int e = gid & 4095, h = (gid >> 12) & 7, b = gid >> 15;
    float st = 0.f;
    for (int c = 0; c < NCH; ++c) { const int ck = b * NCH + c; const size_t off = (size_t)(ck * 8 + h) * 4096 + e;
        PREV[off] = st; st = st * __expf(ACS[(size_t)(ck * 64 + 63) * 8 + h]) + CS[off]; }
}
__global__ void __launch_bounds__(256) k_y_ref(const float* __restrict__ XBC, const float* __restrict__ DTV, const float* __restrict__ ACS, const float* __restrict__ PREV, const float* __restrict__ d_skip, float* __restrict__ YS) {
    const int ck = blockIdx.x, h = blockIdx.y, g = h >> 2, t0 = ck * 64;
    __shared__ float sG[64][65]; __shared__ float sX[64][64]; __shared__ float sP[64][65];
    for (int idx = threadIdx.x; idx < 4096; idx += 256) { const int l = idx >> 6, s = idx & 63; float v = 0.f;
        if (s <= l) { const float* cp = XBC + (size_t)(t0 + l) * 768 + 640 + g * 64; const float* bp = XBC + (size_t)(t0 + s) * 768 + 512 + g * 64;
            for (int n = 0; n < 64; ++n) v += cp[n] * bp[n];
            v *= __expf(ACS[(size_t)(t0 + l) * 8 + h] - ACS[(size_t)(t0 + s) * 8 + h]); }
        sG[l][s] = v;
        sX[l][s] = XBC[(size_t)(t0 + l) * 768 + h * 64 + s] * DTV[(size_t)(t0 + l) * 8 + h];
        sP[l][s] = PREV[((size_t)(ck * 8 + h) * 64 + l) * 64 + s]; }
    __syncthreads();
    const int l = threadIdx.x >> 2, pb = (threadIdx.x & 3) * 16;
    float acc[16];
#pragma unroll
    for (int i = 0; i < 16; ++i) acc[i] = 0.f;
    for (int s = 0; s <= l; ++s) { const float gv = sG[l][s];
#pragma unroll
        for (int i = 0; i < 16; ++i) acc[i] += gv * sX[s][pb + i]; }
    const float* cp = XBC + (size_t)(t0 + l) * 768 + 640 + g * 64; const float el = __expf(ACS[(size_t)(t0 + l) * 8 + h]);
    float off[16];
#pragma unroll
    for (int i = 0; i < 16; ++i) off[i] = 0.f;
    for (int n = 0; n < 64; ++n) { const float cv = cp[n];
#pragma unroll
        for (int i = 0; i < 16; ++i) off[i] += cv * sP[pb + i][n]; }
    const float dsk = d_skip[h];
#pragma unroll
    for (int i = 0; i < 16; ++i) YS[(size_t)(t0 + l) * 512 + h * 64 + pb + i] = acc[i] + off[i] * el + XBC[(size_t)(t0 + l) * 768 + h * 64 + pb + i] * dsk;
}
__global__ void k_gate_ref(const float* __restrict__ YS, const bf16_t* __restrict__ PROJ, const float* __restrict__ norm_g, bf16_t* __restrict__ Y) {
    const int wid = blockIdx.x * 4 + (threadIdx.x >> 6), lane = threadIdx.x & 63, t = wid >> 1, g = wid & 1;
    float v[4]; float ss = 0.f;
#pragma unroll
    for (int i = 0; i < 4; ++i) { const int ch = g * 256 + lane * 4 + i; const float z = bf2f(PROJ[(size_t)t * DINP + C_Z + ch]); v[i] = YS[(size_t)t * 512 + ch] * silu_f(z); ss += v[i] * v[i]; }
    const float rstd = 1.0f / sqrtf(wave_sum(ss) * (1.f / 256.f) + 1e-6f);
#pragma unroll
    for (int i = 0; i < 4; ++i) { const int ch = g * 256 + lane * 4 + i; Y[(size_t)t * DM + 512 + ch] = f2bf(v[i] * rstd * norm_g[ch]); }
}


namespace pg8 {
#define PG8_LAS __attribute__((address_space(3)))
typedef unsigned short bf16_t;
typedef short bf16x8 __attribute__((ext_vector_type(8)));
typedef float f32x4 __attribute__((ext_vector_type(4)));
typedef unsigned u32x4 __attribute__((ext_vector_type(4)));
constexpr int BM = 256, BK = 64, HALF = 128, HTB = HALF * BK * 2  , STAGE_BYTES = 8 * HTB, NXCD = 8, WGM = 8;

__host__ __device__ __forceinline__ int lds_byte(int r, int c) { const int st = (r >> 4) * 2 + (c >> 5), rr = r & 15, cc = c & 31, ob = rr * 64 + cc * 2; return st * 1024 + (ob ^ (((ob >> 9) & 1) << 5)); }
__host__ __device__ __forceinline__ void stage_rc(int b, int& R, int& C) { const int st = b / 1024, sb = b % 1024, swz = sb ^ (((sb >> 9) & 1) << 5); R = (st >> 1) * 16 + swz / 64; C = (st & 1) * 32 + (swz % 64) / 2; }
__host__ __device__ __forceinline__ int perm32(int rho) { const int n = rho >> 4, i = rho & 15; return 8 * (i >> 2) + 4 * n + (i & 3); }

struct Unit { int pm, pn; };
struct Gemm { const bf16_t* A; const bf16_t* Bt; int M, N, K, lda, ldb; };

struct StaticOrder {
    int nM, nN, nwg, G, c;
    __host__ __device__ void init(int M, int N, int G_, int c_) { nM = M / BM; nN = N / BM; nwg = nM * nN; G = G_; c = c_; }
    __host__ __device__ bool next(int i, Unit& u) const {
        const long L = (long)i * G + c; if (L >= nwg) return false;
        int wgid = (int)L; { const int q = nwg / NXCD, r = nwg % NXCD, xcd = wgid % NXCD, off = wgid / NXCD; wgid = (xcd < r ? xcd * (q + 1) : r * (q + 1) + (xcd - r) * q) + off; }
        const int nig = WGM * nN, gid = wgid / nig, fm = gid * WGM, gsz = (nM - fm) < WGM ? (nM - fm) : WGM;
        u.pm = fm + ((wgid % nig) % gsz); u.pn = (wgid % nig) / gsz; return true;
    }
    __device__ __forceinline__ void a_ready(const Unit&) const {}
    __device__ __forceinline__ void done(const Unit&) const {}
};
__device__ __forceinline__ unsigned cvt_pk_bf16(float lo, float hi) { unsigned r; asm volatile("v_cvt_pk_bf16_f32 %0, %1, %2" : "=v"(r) : "v"(lo), "v"(hi)); return r; }
typedef float f32x2 __attribute__((ext_vector_type(2)));
template <class Epi, class Sched, bool ALIGN_EPI = false, bool SP2 = false>
__device__ __forceinline__ void gemm_phase(PG8_LAS unsigned char* lds, const Gemm g, const Sched& S, const Epi& E) {
    int tid_ = threadIdx.x; asm volatile("" : "+v"(tid_));
    const int tid = tid_, wid = __builtin_amdgcn_readfirstlane(tid >> 6), lane = tid & 63, wr = wid >> 2, wc = wid & 3, fr = lane & 15, fq = lane >> 4;
    const int K = g.K, nt = K / BK;
    unsigned voffA[2], voffB[2];
#pragma unroll
    for (int i = 0; i < 2; ++i) { int R, C; stage_rc(tid * 16 + i * 8192, R, C); const int Rb = Epi::PERM ? ((R & ~31) + perm32(R & 31)) : R;
        voffA[i] = (unsigned)(R * g.lda + C) * 2u; voffB[i] = (unsigned)(Rb * g.ldb + C) * 2u; }
    const size_t kstep = (size_t)(BK * 2);
    const size_t hstepA = (size_t)HALF * g.lda * 2, hstepB = (size_t)HALF * g.ldb * 2;
    const size_t tstepA = 2 * hstepA, tstepB = 2 * hstepB;
    const unsigned ldsw = (unsigned)wid * 1024u;
    const int aoff = lds_byte(wr * 64 + fr, fq * 8), boff = lds_byte(wc * 32 + fr, fq * 8);
#define PG8_SA(b, h) (((b) * 2 + (h)) * HTB)
#define PG8_SB(b, h) ((4 + (b) * 2 + (h)) * HTB)
#define PG8_STAGE(bufoff, gbase, voff) do { _Pragma("unroll") for (int _i = 0; _i < 2; ++_i) \
        __builtin_amdgcn_global_load_lds((const unsigned*)((const char*)(gbase) + (voff)[_i]), (PG8_LAS unsigned*)(lds + (bufoff) + ldsw + _i * 8192), 16, 0, 0); } while (0)
#define PG8_LDA(dst, b, h) do { _Pragma("unroll") for (int m = 0; m < 4; ++m) _Pragma("unroll") for (int k = 0; k < 2; ++k) dst[m][k] = *(const PG8_LAS bf16x8*)(lds + PG8_SA(b, h) + aoff + m * 2048 + k * 1024); } while (0)
#define PG8_LDB(dst, b, h) do { _Pragma("unroll") for (int n = 0; n < 2; ++n) _Pragma("unroll") for (int k = 0; k < 2; ++k) dst[n][k] = *(const PG8_LAS bf16x8*)(lds + PG8_SB(b, h) + boff + n * 2048 + k * 1024); } while (0)
#define PG8_MMA(ai, bj, At, Bt) do { __builtin_amdgcn_s_setprio(1); _Pragma("unroll") for (int m = 0; m < 4; ++m) _Pragma("unroll") for (int n = 0; n < 2; ++n) _Pragma("unroll") for (int k = 0; k < 2; ++k) \
        acc[ai][bj][m][n] = __builtin_amdgcn_mfma_f32_16x16x32_bf16(Bt[n][k], At[m][k], acc[ai][bj][m][n], 0, 0, 0); __builtin_amdgcn_s_setprio(0); } while (0)
#define PG8_WAIT_V(n) asm volatile("s_waitcnt vmcnt(" #n ")" ::: "memory")
#define PG8_WAIT_L(n) asm volatile("s_waitcnt lgkmcnt(" #n ")" ::: "memory")
#define PG8_BAR __builtin_amdgcn_s_barrier()
#define PG8_SCHED __builtin_amdgcn_sched_barrier(0)
    Unit cur, nxt; int ui = 0;
    if (!S.next(0, cur)) return;
    f32x4 acc[2][2][4][2];
#pragma unroll
    for (int a = 0; a < 2; ++a)
#pragma unroll
        for (int b = 0; b < 2; ++b)
#pragma unroll
            for (int m = 0; m < 4; ++m)
#pragma unroll
                for (int n = 0; n < 2; ++n) acc[a][b][m][n] = (f32x4){0.f, 0.f, 0.f, 0.f};
    bf16x8 At[4][2], B0[2][2], B1[2][2];
    const char* cA = (const char*)g.A + (size_t)cur.pm * tstepA; const char* cB = (const char*)g.Bt + (size_t)cur.pn * tstepB;
    S.a_ready(cur);
    if constexpr (SP2) {
        PG8_STAGE(PG8_SB(0, 0), cB, voffB); PG8_STAGE(PG8_SB(0, 1), cB + hstepB, voffB); PG8_STAGE(PG8_SA(0, 0), cA, voffA); PG8_STAGE(PG8_SA(0, 1), cA + hstepA, voffA);
        if (wr == 1) PG8_BAR;
        PG8_WAIT_V(2); PG8_BAR;
        PG8_STAGE(PG8_SB(1, 0), cB + kstep, voffB); PG8_STAGE(PG8_SA(1, 0), cA + kstep, voffA); PG8_STAGE(PG8_SB(1, 1), cB + hstepB + kstep, voffB);
        PG8_WAIT_V(6); PG8_BAR;
    } else {
        PG8_STAGE(PG8_SB(0, 0), cB, voffB); PG8_STAGE(PG8_SA(0, 0), cA, voffA); PG8_STAGE(PG8_SB(0, 1), cB + hstepB, voffB); PG8_STAGE(PG8_SA(0, 1), cA + hstepA, voffA);
        if (wr == 1) PG8_BAR;
        PG8_WAIT_V(4); PG8_BAR;
        PG8_STAGE(PG8_SB(1, 0), cB + kstep, voffB); PG8_STAGE(PG8_SA(1, 0), cA + kstep, voffA); PG8_STAGE(PG8_SB(1, 1), cB + hstepB + kstep, voffB);
        PG8_WAIT_V(6); PG8_BAR;
    }
    for (;;) {
        const bool has_next = S.next(ui + 1, nxt);
        const char* nA = has_next ? (const char*)g.A + (size_t)nxt.pm * tstepA : cA; const char* nB = has_next ? (const char*)g.Bt + (size_t)nxt.pn * tstepB : cB;
        for (int t = 0; t < nt; t += 2) {
            const bool last = (t == nt - 2);
            const char* a1 = cA + (size_t)(t + 1) * kstep;
            const char* a2 = last ? nA : cA + (size_t)(t + 2) * kstep; const char* b2 = last ? nB : cB + (size_t)(t + 2) * kstep;
            const char* a3 = a2 + kstep; const char* b3 = b2 + kstep;
            if (last && has_next) S.a_ready(nxt);
            if constexpr (SP2) {
            PG8_LDB(B0, 0, 0); PG8_LDB(B1, 0, 1); PG8_SCHED; PG8_LDA(At, 0, 0); PG8_STAGE(PG8_SA(1, 1), a1 + hstepA, voffA);
            PG8_WAIT_V(8); PG8_WAIT_L(0); PG8_BAR; PG8_MMA(0, 0, At, B0); PG8_MMA(0, 1, At, B1); PG8_BAR; PG8_SCHED;
            PG8_LDA(At, 0, 1); PG8_STAGE(PG8_SB(0, 0), b2, voffB); PG8_STAGE(PG8_SB(0, 1), b2 + hstepB, voffB); PG8_STAGE(PG8_SA(0, 0), a2, voffA);
            PG8_WAIT_V(8); PG8_WAIT_L(0); PG8_BAR; PG8_MMA(1, 0, At, B0); PG8_MMA(1, 1, At, B1); PG8_BAR; PG8_SCHED;
            PG8_LDB(B0, 1, 0); PG8_LDB(B1, 1, 1); PG8_SCHED; PG8_LDA(At, 1, 0); PG8_STAGE(PG8_SA(0, 1), a2 + hstepA, voffA);
            PG8_WAIT_V(8); PG8_WAIT_L(0); PG8_BAR; PG8_MMA(0, 0, At, B0); PG8_MMA(0, 1, At, B1); PG8_BAR; PG8_SCHED;
            PG8_LDA(At, 1, 1); PG8_STAGE(PG8_SB(1, 0), b3, voffB); PG8_STAGE(PG8_SB(1, 1), b3 + hstepB, voffB); PG8_STAGE(PG8_SA(1, 0), a3, voffA);
            PG8_WAIT_V(8); PG8_WAIT_L(0); PG8_BAR; PG8_MMA(1, 0, At, B0); PG8_MMA(1, 1, At, B1); PG8_BAR; PG8_SCHED;
            } else {
            PG8_LDB(B0, 0, 0); PG8_SCHED; PG8_LDA(At, 0, 0); PG8_STAGE(PG8_SA(1, 1), a1 + hstepA, voffA);
            PG8_WAIT_L(8); PG8_BAR; PG8_WAIT_L(0); PG8_MMA(0, 0, At, B0); PG8_BAR; PG8_SCHED;
            PG8_LDB(B1, 0, 1); PG8_STAGE(PG8_SB(0, 0), b2, voffB);
            PG8_BAR; PG8_WAIT_L(0); PG8_MMA(0, 1, At, B1); PG8_BAR;
            PG8_LDA(At, 0, 1); PG8_STAGE(PG8_SA(0, 0), a2, voffA);
            PG8_BAR; PG8_WAIT_L(0); PG8_MMA(1, 0, At, B0); PG8_BAR; PG8_SCHED;
            PG8_STAGE(PG8_SB(0, 1), b2 + hstepB, voffB);
            PG8_WAIT_V(6); PG8_BAR; PG8_MMA(1, 1, At, B1); PG8_BAR;
            PG8_LDB(B0, 1, 0); PG8_SCHED; PG8_LDA(At, 1, 0); PG8_STAGE(PG8_SA(0, 1), a2 + hstepA, voffA);
            PG8_WAIT_L(8); PG8_BAR; PG8_WAIT_L(0); PG8_MMA(0, 0, At, B0); PG8_BAR; PG8_SCHED;
            PG8_LDB(B1, 1, 1); PG8_STAGE(PG8_SB(1, 0), b3, voffB);
            PG8_BAR; PG8_WAIT_L(0); PG8_MMA(0, 1, At, B1); PG8_BAR;
            PG8_LDA(At, 1, 1); PG8_STAGE(PG8_SA(1, 0), a3, voffA);
            PG8_BAR; PG8_WAIT_L(0); PG8_MMA(1, 0, At, B0); PG8_BAR; PG8_SCHED;
            PG8_STAGE(PG8_SB(1, 1), b3 + hstepB, voffB);
            PG8_WAIT_V(6); PG8_BAR; PG8_MMA(1, 1, At, B1); PG8_BAR;
            }
        }
        if constexpr (ALIGN_EPI) { if (wr == 0) PG8_BAR; }
        if constexpr (!Epi::AFTER_DRAIN) { E(acc, cur, wr, wc, fr, fq); S.done(cur); }
        if (!has_next) break;
#pragma unroll
        for (int a = 0; a < 2; ++a)
#pragma unroll
            for (int b = 0; b < 2; ++b)
#pragma unroll
                for (int m = 0; m < 4; ++m)
#pragma unroll
                    for (int n = 0; n < 2; ++n) acc[a][b][m][n] = (f32x4){0.f, 0.f, 0.f, 0.f};
        cur = nxt; cA = nA; cB = nB; ++ui;
        if constexpr (ALIGN_EPI) { if (wr == 1) PG8_BAR; }
    }
    PG8_WAIT_V(0);
    if constexpr (!ALIGN_EPI) { if (wr == 0) PG8_BAR; }
    PG8_BAR;
    if constexpr (Epi::AFTER_DRAIN) { E.fused(acc, cur, wr, wc, fr, fq, lds, wid, lane); S.done(cur); }
#undef PG8_SA
#undef PG8_SB
#undef PG8_STAGE
#undef PG8_LDA
#undef PG8_LDB
#undef PG8_MMA
#undef PG8_WAIT_V
#undef PG8_WAIT_L
#undef PG8_BAR
#undef PG8_SCHED
}
}

namespace pg8 {
struct EpiIn {
    static constexpr bool PERM = true, AFTER_DRAIN = false;
    bf16_t* O; float* DTF;
    __device__ __forceinline__ void operator()(const f32x4 (&acc)[2][2][4][2], const Unit& u, int wr, int wc, int fr, int fq) const {
        const int row0 = u.pm * BM + wr * 64 + fr, col0 = u.pn * BM + wc * 32 + 8 * fq;
        const float sc = (u.pn == 0) ? DA_SCALE : 1.f;
        const bool dtl = (u.pn == 9) && (wc == 1) && (fq == 0);
#pragma unroll
        for (int ai = 0; ai < 2; ++ai)
#pragma unroll
            for (int m = 0; m < 4; ++m) { const int row = row0 + ai * HALF + m * 16; bf16_t* rowp = O + (size_t)row * DINP + col0;
#pragma unroll
                for (int bj = 0; bj < 2; ++bj) { const f32x4 v0 = acc[ai][bj][m][0] * sc, v1 = acc[ai][bj][m][1] * sc;
                    u32x4 w; w.x = cvt_pk_bf16(v0[0], v0[1]); w.y = cvt_pk_bf16(v0[2], v0[3]); w.z = cvt_pk_bf16(v1[0], v1[1]); w.w = cvt_pk_bf16(v1[2], v1[3]);
                    *(u32x4*)(rowp + bj * HALF) = w;
                    if (bj == 1 && dtl) { *(f32x4*)(DTF + (size_t)row * 8) = v0; *(f32x4*)(DTF + (size_t)row * 8 + 4) = v1; } } }
    }
};
struct EpiF32 {
    static constexpr bool PERM = false, AFTER_DRAIN = false;
    float* C; int ldc;
    __device__ __forceinline__ void operator()(const f32x4 (&acc)[2][2][4][2], const Unit& u, int wr, int wc, int fr, int fq) const {
        const int row0 = u.pm * BM + wr * 64 + fr, col0 = u.pn * BM + wc * 32 + 4 * fq;
#pragma unroll
        for (int ai = 0; ai < 2; ++ai)
#pragma unroll
            for (int m = 0; m < 4; ++m) { float* rowp = C + (size_t)(row0 + ai * HALF + m * 16) * ldc + col0;
#pragma unroll
                for (int bj = 0; bj < 2; ++bj)
#pragma unroll
                    for (int n = 0; n < 2; ++n) *(f32x4*)(rowp + bj * HALF + n * 16) = acc[ai][bj][m][n]; }
    }
};
struct EpiSqRelu {
    static constexpr bool PERM = true, AFTER_DRAIN = false;
    bf16_t* O; int ldc;
    __device__ __forceinline__ void operator()(const f32x4 (&acc)[2][2][4][2], const Unit& u, int wr, int wc, int fr, int fq) const {
        const int row0 = u.pm * BM + wr * 64 + fr, col0 = u.pn * BM + wc * 32 + 8 * fq;
#pragma unroll
        for (int ai = 0; ai < 2; ++ai)
#pragma unroll
            for (int m = 0; m < 4; ++m) { bf16_t* rowp = O + (size_t)(row0 + ai * HALF + m * 16) * ldc + col0;
#pragma unroll
                for (int bj = 0; bj < 2; ++bj) { f32x4 v0 = acc[ai][bj][m][0], v1 = acc[ai][bj][m][1];
#pragma unroll
                    for (int e = 0; e < 4; ++e) { const float a = fmaxf(v0[e], 0.f), b = fmaxf(v1[e], 0.f); v0[e] = a * a; v1[e] = b * b; }
                    u32x4 w; w.x = cvt_pk_bf16(v0[0], v0[1]); w.y = cvt_pk_bf16(v0[2], v0[3]); w.z = cvt_pk_bf16(v1[0], v1[1]); w.w = cvt_pk_bf16(v1[2], v1[3]);
                    *(u32x4*)(rowp + bj * HALF) = w; } }
    }
};
}


namespace att {
typedef __attribute__((ext_vector_type(16))) float f32x16;
typedef __attribute__((ext_vector_type(4))) short s16x4;
typedef __attribute__((ext_vector_type(4))) unsigned u32x4;
typedef __attribute__((address_space(3))) const char* lds_cptr;
typedef short v4i16_t __attribute__((ext_vector_type(4)));
typedef float f32x2_t __attribute__((ext_vector_type(2))); typedef __bf16 bf16x2_t __attribute__((ext_vector_type(2)));
constexpr int L_K = 0, SLOTK_MAX = 12288, L_V = 3 * SLOTK_MAX, SLOTV = 8192, L_WS = L_V + 3 * SLOTV, L_OST = L_WS + 8 * 512, L_END = L_OST + 8 * 8192;
static_assert(L_END <= 131072, "attention LDS map");
constexpr float THR = 8.0f;
__device__ __forceinline__ int crow(int r, int hi) { return (r & 3) + 8 * (r >> 2) + 4 * hi; }
__device__ __forceinline__ void glds16(const void* gsrc, unsigned lds_dst) { unsigned keep;
    asm volatile("s_mov_b32 %0, m0\n\ts_mov_b32 m0, %2\n\ts_nop 0\n\tglobal_load_lds_dwordx4 %1, off\n\ts_mov_b32 m0, %0" : "=&s"(keep) : "v"(gsrc), "s"(lds_dst) : "memory"); }
__device__ __forceinline__ unsigned cvtpk(float lo, float hi) { f32x2_t v = {lo, hi}; bf16x2_t b = __builtin_convertvector(v, bf16x2_t); return __builtin_bit_cast(unsigned, b); }
__device__ __forceinline__ s16x4 vtr(lds_cptr p) { return __builtin_bit_cast(s16x4, __builtin_amdgcn_ds_read_tr16_b64_v4i16((__attribute__((address_space(3))) v4i16_t*)p)); }
__device__ __forceinline__ bf16x8 kld(lds_cptr p) { return *(const __attribute__((address_space(3))) bf16x8*)p; }
#define ATT_MFMA(a, b, c) __builtin_amdgcn_mfma_f32_32x32x16_bf16((a), (b), (c), 0, 0, 0)
#define ATT_WAIT_BAR(N) asm volatile("s_waitcnt vmcnt(" #N ") lgkmcnt(0)\n\ts_barrier" ::: "memory")
__device__ __forceinline__ float rowmax(const f32x16& p0, const f32x16& p1) {
    float a = fmaxf(p0[0], p1[0]);
#pragma unroll
    for (int r = 1; r < 16; ++r) a = fmaxf(a, fmaxf(p0[r], p1[r]));
    auto rr = __builtin_amdgcn_permlane32_swap(__float_as_uint(a), __float_as_uint(a), false, false);
    return fmaxf(__uint_as_float(rr[0]), __uint_as_float(rr[1]));
}
__device__ __forceinline__ void softmax_step(f32x16& p0, f32x16& p1, float& m, float& l, f32x16 (&o)[2], volatile __attribute__((address_space(3))) float* fs, int r32, int hi) {
    const float rm = rowmax(p0, p1);
    if (__any(rm - m > THR)) {
        const float mn = fmaxf(m, rm), f = __builtin_amdgcn_exp2f(m - mn);
        l *= f; m = mn;
        if (hi == 0) fs[r32] = f;
        asm volatile("s_waitcnt lgkmcnt(0)" ::: "memory");
#pragma unroll
        for (int r = 0; r < 16; ++r) { const float fr = fs[crow(r, hi)]; o[0][r] *= fr; o[1][r] *= fr; }
    }
    float sum = 0.f;
#pragma unroll
    for (int r = 0; r < 16; ++r) { p0[r] = __builtin_amdgcn_exp2f(p0[r] - m); p1[r] = __builtin_amdgcn_exp2f(p1[r] - m); sum += p0[r] + p1[r]; }
    l += sum;
}
__device__ __forceinline__ bf16x8 pfrag(const f32x16& p, int b) { u32x4 w; w.x = cvtpk(p[b], p[b + 1]); w.y = cvtpk(p[b + 2], p[b + 3]); w.z = cvtpk(p[b + 4], p[b + 5]); w.w = cvtpk(p[b + 6], p[b + 7]); return __builtin_bit_cast(bf16x8, w); }
__device__ __forceinline__ bf16x8 vfrag(lds_cptr vp, int i) { const s16x4 lo = vtr(vp + ((i >> 2) * 4096 + (i & 3) * 1024)), hi = vtr(vp + ((i >> 2) * 4096 + (i & 3) * 1024 + 512));
    return (bf16x8){lo[0], lo[1], lo[2], lo[3], hi[0], hi[1], hi[2], hi[3]}; }
__device__ __forceinline__ void pv(f32x16 (&o)[2], const f32x16& p0, const f32x16& p1, lds_cptr vp) {
    const bf16x8 a0 = pfrag(p0, 0), a1 = pfrag(p0, 8), a2 = pfrag(p1, 0), a3 = pfrag(p1, 8);
#pragma unroll
    for (int dh = 0; dh < 2; ++dh) {
        o[dh] = ATT_MFMA(a0, vfrag(vp, dh * 4 + 0), o[dh]); o[dh] = ATT_MFMA(a1, vfrag(vp, dh * 4 + 1), o[dh]);
        o[dh] = ATT_MFMA(a2, vfrag(vp, dh * 4 + 2), o[dh]); o[dh] = ATT_MFMA(a3, vfrag(vp, dh * 4 + 3), o[dh]); }
}
template <int ND> __device__ __forceinline__ void qk(f32x16& p0, f32x16& p1, lds_cptr kp, int d0b, const bf16x8* qr) {
    f32x16 z = f32x16{};
#pragma unroll
    for (int d = 0; d < ND; ++d) { const bf16x8 k0 = kld(kp + (d0b + d) * 2048), k1 = kld(kp + (d0b + d) * 2048 + 512);
        p0 = ATT_MFMA(k0, qr[d0b + d], d == 0 ? z : p0); p1 = ATT_MFMA(k1, qr[d0b + d], d == 0 ? z : p1); }
}

template <int KIND>
__device__ __forceinline__ void attn_unit(int qb, const bf16_t* Qb, int ldq, const bf16_t* Kb, int ldk, const bf16_t* Vb, int ldv, bf16_t* Yb, float lam, const float* subln_g, float oml, char* shm) {
    constexpr int NQ = KIND == 0 ? 4 : 6, SLOTK = 2 * NQ * 1024;
    int tid_ = threadIdx.x; asm volatile("" : "+v"(tid_));
    const int tid = tid_, lane = tid & 63, r32 = lane & 31, hi = lane >> 5; const int wid = __builtin_amdgcn_readfirstlane(tid >> 6);
    const int q0 = qb * 256, NT = 4 * qb + 4, ntw = 4 * qb + (wid >> 1) + 1;
    const unsigned lds0 = (unsigned)(uintptr_t)shm;
    volatile __attribute__((address_space(3))) float* wsf = (volatile __attribute__((address_space(3))) float*)((lds_cptr)shm + L_WS) + wid * 128;
    const bf16_t* ksrc = Kb + (size_t)lane * ldk + wid * 8;
    const bf16_t* vsrc = Vb + (size_t)(16 * (wid & 3) + (lane >> 2)) * ldv + (wid >> 2) * 32 + (lane & 3) * 8;
    const unsigned kdst = lds0 + L_K + wid * 1024, vdst = lds0 + L_V + wid * 1024;
    const bool k2 = (KIND == 1) && (wid < 4);
#define ATT_DMA(t, slot) do { glds16(ksrc + (size_t)(t) * 64 * ldk, (unsigned)__builtin_amdgcn_readfirstlane(kdst + (slot) * SLOTK)); \
        if (k2) glds16(ksrc + (size_t)(t) * 64 * ldk + 64, (unsigned)__builtin_amdgcn_readfirstlane(kdst + (slot) * SLOTK + 8192)); \
        glds16(vsrc + (size_t)(t) * 64 * ldv, (unsigned)__builtin_amdgcn_readfirstlane(vdst + (slot) * SLOTV)); } while (0)
    const lds_cptr kp0 = (lds_cptr)shm + L_K + hi * 1024 + r32 * 16;
    const lds_cptr vp0 = (lds_cptr)shm + L_V + ((lane >> 4) & 1) * 32 + (lane & 3) * 8 + (4 * hi + ((lane & 15) >> 2)) * 64;
    bf16x8 qr[NQ];
    { const bf16_t* Qw = Qb + (size_t)(q0 + wid * 32 + r32) * ldq + hi * 8;
#pragma unroll
      for (int d = 0; d < NQ; ++d) qr[d] = *(const bf16x8*)(Qw + d * 16); }
    ATT_DMA(0, 0); ATT_DMA(1, 1);
    float m1 = -1e30f, l1 = 0.f, m2 = -1e30f, l2 = 0.f;
    f32x16 o1[2], o2[2]; o1[0] = f32x16{}; o1[1] = f32x16{}; o2[0] = f32x16{}; o2[1] = f32x16{};
    int slot = 0, slot2 = 2;
    for (int t = 0; t < NT; ++t) {
        if (t + 1 < NT) { if (k2) ATT_WAIT_BAR(3); else ATT_WAIT_BAR(2); } else ATT_WAIT_BAR(0);
        if (t + 2 < NT) ATT_DMA(t + 2, slot2);
        if (t < ntw) {
            const lds_cptr kp = kp0 + slot * SLOTK, vp = vp0 + slot * SLOTV;
            f32x16 p0, p1;
            if (KIND == 0) {
                qk<2>(p0, p1, kp, 0, qr); softmax_step(p0, p1, m1, l1, o1, wsf, r32, hi); pv(o1, p0, p1, vp);
                qk<2>(p0, p1, kp, 2, qr); softmax_step(p0, p1, m2, l2, o2, wsf + 32, r32, hi); pv(o2, p0, p1, vp);
            } else {
                qk<6>(p0, p1, kp, 0, qr); softmax_step(p0, p1, m1, l1, o1, wsf, r32, hi); pv(o1, p0, p1, vp);
            }
        }
        slot = (slot == 2) ? 0 : slot + 1; slot2 = (slot2 == 2) ? 0 : slot2 + 1;
    }
#undef ATT_DMA
    { auto rr = __builtin_amdgcn_permlane32_swap(__float_as_uint(l1), __float_as_uint(l1), false, false); l1 = __uint_as_float(rr[0]) + __uint_as_float(rr[1]); }
    if (KIND == 0) { auto rr = __builtin_amdgcn_permlane32_swap(__float_as_uint(l2), __float_as_uint(l2), false, false); l2 = __uint_as_float(rr[0]) + __uint_as_float(rr[1]); }
    if (hi == 0) { wsf[64 + r32] = 1.0f / l1; if (KIND == 0) wsf[96 + r32] = lam / l2; }
    asm volatile("s_waitcnt lgkmcnt(0)" ::: "memory");
    __attribute__((address_space(3))) float* stg = (__attribute__((address_space(3))) float*)((lds_cptr)shm + L_OST) + wid * 2048;
#pragma unroll
    for (int r = 0; r < 16; ++r) { const int orow = crow(r, hi); const float s1 = wsf[64 + orow]; float s2 = 0.f; if (KIND == 0) s2 = wsf[96 + orow];
#pragma unroll
        for (int dh = 0; dh < 2; ++dh) { float v = o1[dh][r] * s1; if (KIND == 0) v -= o2[dh][r] * s2; stg[orow * 64 + dh * 32 + r32] = v; } }
    asm volatile("s_waitcnt lgkmcnt(0)" ::: "memory");
    bf16_t* Yw = Yb + (size_t)(q0 + wid * 32) * DM;
#pragma unroll
    for (int i = 0; i < 4; ++i) { const int row = i * 8 + (lane >> 3), ch = lane & 7;
        f32x4 va = *(const __attribute__((address_space(3))) f32x4*)(stg + row * 64 + ch * 8), vb = *(const __attribute__((address_space(3))) f32x4*)(stg + row * 64 + ch * 8 + 4);
        if (KIND == 0) {
            float ss = va[0] * va[0] + va[1] * va[1] + va[2] * va[2] + va[3] * va[3] + vb[0] * vb[0] + vb[1] * vb[1] + vb[2] * vb[2] + vb[3] * vb[3];
            ss += __shfl_xor(ss, 1); ss += __shfl_xor(ss, 2); ss += __shfl_xor(ss, 4);
            const float rstd = oml / sqrtf(ss * (1.f / 64.f) + 1e-5f);
            const f32x4 ga = *(const f32x4*)(subln_g + ch * 8), gb = *(const f32x4*)(subln_g + ch * 8 + 4);
            va = va * rstd * ga; vb = vb * rstd * gb; }
        u32x4 w; w.x = cvtpk(va[0], va[1]); w.y = cvtpk(va[2], va[3]); w.z = cvtpk(vb[0], vb[1]); w.w = cvtpk(vb[2], vb[3]);
        *(u32x4*)(Yw + (size_t)row * DM + ch * 8) = w; }
    asm volatile("s_waitcnt lgkmcnt(0)\n\ts_barrier" ::: "memory");
}
#undef ATT_MFMA
#undef ATT_WAIT_BAR
}

constexpr int NWAVES = 8;
constexpr int RING_OFF = 0, RING_BYTES = 131072;
constexpr int LDSCTL_OFF = RING_BYTES, MISC_OFF = LDSCTL_OFF + 320;
constexpr int LDS_BYTES = 147456;
#define LAS __attribute__((address_space(3)))
#define GAS __attribute__((address_space(1)))
typedef GAS unsigned gu32;
#define RLX_AGENT __ATOMIC_RELAXED, __HIP_MEMORY_SCOPE_AGENT
constexpr int PH_PRO = 0, PH_PER_LAYER = 9, PH_IN = 0, PH_PREP = 1, PH_SCAN = 2, PH_MIX = 3, PH_OUT = 4, PH_RN1 = 5, PH_UP = 6, PH_DN = 7, PH_RN2 = 8, PH_TOTAL = 1 + DEPTH * PH_PER_LAYER;

struct Args { const void* in[22]; float* out; unsigned char* ws; int ph_lo, ph_hi; };

__global__ void __launch_bounds__(NWAVES * 64, 2) mega(Args args) {
    extern __shared__ __attribute__((aligned(16))) unsigned char lds[];
    LAS unsigned char* L = (LAS unsigned char*)lds;
    unsigned char* ws = args.ws;
    const int lo = args.ph_lo, hi = args.ph_hi;
#pragma unroll 1
    for (int l = 0; l < DEPTH; ++l) {
        const int base = 1 + l * PH_PER_LAYER;
        unsigned char* wl = ws + WS_W0 + (size_t)l * W_LAYER;
        if (lo <= base + PH_MIX && base + PH_MIX < hi) {
            const int G = gridDim.x, bx = blockIdx.x, vcu = (G % 8 == 0) ? (bx % 8) * (G / 8) + bx / 8 : bx;
            const int bh = vcu >> 3, sidx = vcu & 7, b = bh >> 2, h = bh & 3;
            const float* lp = (const float*)args.in[7] + l * 128; float ls0 = 0.f, ls1 = 0.f;
            for (int i = 0; i < 32; ++i) { ls0 += lp[i] * lp[32 + i]; ls1 += lp[64 + i] * lp[96 + i]; }
            const float lambda_init = (l == 0) ? 0.2f : (float)(0.8 - 0.6 * 0.7408182206817179);
            const float lam = __expf(ls0) - __expf(ls1) + lambda_init;
            const bf16_t* PROJ = (const bf16_t*)(ws + WS_PROJ) + (size_t)b * SEQ * DINP; bf16_t* Yb = (bf16_t*)(ws + WS_Y) + (size_t)b * SEQ * DM;
            const bf16_t* QMb = (const bf16_t*)(ws + WS_QM) + (size_t)b * SEQ * 384 + h * 96; const bf16_t* KMb = (const bf16_t*)(ws + WS_KM) + (size_t)b * SEQ * 384 + h * 96; const bf16_t* VMb = (const bf16_t*)(ws + WS_VM) + (size_t)b * SEQ * 256 + h * 64;
            const float* sg = (const float*)args.in[8] + l * 64;
            if (bh < 32) {
#pragma unroll 1
                for (int i = 0; i < 2; ++i) { const int qb = i == 0 ? 15 - sidx : sidx;
                    att::attn_unit<0>(qb, PROJ + C_AQ + h * 64, DINP, PROJ + C_AK + h * 64, DINP, PROJ + C_AV + h * 64, DINP, Yb + h * 64, lam, sg, 1.f - lambda_init, (char*)lds + RING_OFF); }
#pragma unroll 1
                for (int i = 0; i < 2; ++i) { const int qb = i == 0 ? 15 - sidx : sidx;
                    att::attn_unit<1>(qb, QMb, 384, KMb, 384, VMb, 256, Yb + 256 + h * 64, 0.f, sg, 1.f, (char*)lds + RING_OFF); }
            }
        }
        if (lo <= base + PH_IN && base + PH_IN < hi) {
            pg8::Gemm g{(const bf16_t*)(ws + WS_XN), (const bf16_t*)(wl + W_IN), T, DINP, DM, DM, DM}; pg8::StaticOrder S; S.init(T, DINP, gridDim.x, (int)blockIdx.x);
            pg8::EpiIn E{(bf16_t*)(ws + WS_PROJ), (float*)(ws + WS_DTF)};
            pg8::gemm_phase<pg8::EpiIn, pg8::StaticOrder, true, true>(L + RING_OFF, g, S, E);
        }
        if (lo <= base + PH_OUT && base + PH_OUT < hi) {
            pg8::Gemm g{(const bf16_t*)(ws + WS_Y), (const bf16_t*)(wl + W_OUT), T, DM, DM, DM, DM}; pg8::StaticOrder S; S.init(T, DM, gridDim.x, (int)blockIdx.x);
            pg8::EpiF32 E{(float*)(ws + WS_YO), DM};
            pg8::gemm_phase<pg8::EpiF32, pg8::StaticOrder, true, true>(L + RING_OFF, g, S, E);
        }
        if (lo <= base + PH_UP && base + PH_UP < hi) {
            pg8::Gemm g{(const bf16_t*)(ws + WS_XN), (const bf16_t*)(wl + W_UP), T, DFF, DM, DM, DM}; pg8::StaticOrder S; S.init(T, DFF, gridDim.x, (int)blockIdx.x);
            pg8::EpiSqRelu E{(bf16_t*)(ws + WS_H), DFF};
            pg8::gemm_phase<pg8::EpiSqRelu, pg8::StaticOrder, true, true>(L + RING_OFF, g, S, E);
        }
        if (lo <= base + PH_DN && base + PH_DN < hi) {
            pg8::Gemm g{(const bf16_t*)(ws + WS_H), (const bf16_t*)(wl + W_DN), T, DM, DFF, DFF, DFF}; pg8::StaticOrder S; S.init(T, DM, gridDim.x, (int)blockIdx.x);
            pg8::EpiF32 E{(float*)(ws + WS_YO), DM};
            pg8::gemm_phase<pg8::EpiF32, pg8::StaticOrder, true, true>(L + RING_OFF, g, S, E);
        }
    }
}

static void launch_mega(Args a, int lo, int hi, hipStream_t stream) { a.ph_lo = lo; a.ph_hi = hi; hipLaunchKernelGGL(mega, dim3(256), dim3(NWAVES * 64), LDS_BYTES, stream, a); }
extern "C" void kernel_launch(void* const* d_in, const int* in_sizes, int n_in, void* d_out, int out_size, void* d_ws, size_t ws_size, hipStream_t stream) {
    if (n_in != 22 || out_size != T * DM || ws_size < WS_END) { fprintf(stderr, "kernel_launch: unexpected shapes (n_in %d out %d ws %zu)\n", n_in, out_size, ws_size); return; }
    static int inited = 0;
    if (!inited) { if (hipFuncSetAttribute((const void*)mega, hipFuncAttributeMaxDynamicSharedMemorySize, LDS_BYTES) != hipSuccess) fprintf(stderr, "hipFuncSetAttribute failed\n"); inited = 1; }
    const float* x = (const float*)d_in[0]; const float* c = (const float*)d_in[1]; const int* pos = (const int*)d_in[2];
    const float* w_ada = (const float*)d_in[3]; const float* b_ada = (const float*)d_in[4]; const float* norm_g = (const float*)d_in[5];
    const float* w_in = (const float*)d_in[6]; const float* diff_lambda = (const float*)d_in[7]; const float* subln_g = (const float*)d_in[8];
    const float* q_norm_g = (const float*)d_in[9]; const float* w_uq = (const float*)d_in[10]; const float* kv_norm_g = (const float*)d_in[11]; const float* w_ukv = (const float*)d_in[12];
    const float* conv_w = (const float*)d_in[13]; const float* conv_b = (const float*)d_in[14]; const float* dt_bias = (const float*)d_in[15]; const float* a_log = (const float*)d_in[16];
    const float* d_skip = (const float*)d_in[17]; const float* ssm_norm_g = (const float*)d_in[18]; const float* w_out = (const float*)d_in[19]; const float* w_up = (const float*)d_in[20]; const float* w_down = (const float*)d_in[21];
    char* ws = (char*)d_ws; float* out = (float*)d_out;
    Args a{}; for (int i = 0; i < 22; ++i) a.in[i] = d_in[i]; a.out = out; a.ws = (unsigned char*)d_ws;
    float* MOD = (float*)(ws + WS_MOD); float* COS = (float*)(ws + WS_COS); float* SIN = (float*)(ws + WS_SIN); float* DTF = (float*)(ws + WS_DTF); float* ACS = (float*)(ws + WS_ACS); float* DTV = (float*)(ws + WS_DTV);
    bf16_t* XN = (bf16_t*)(ws + WS_XN); bf16_t* Y = (bf16_t*)(ws + WS_Y); float* YO = (float*)(ws + WS_YO);
    bf16_t* PROJ = (bf16_t*)(ws + WS_PROJ); bf16_t* QM = (bf16_t*)(ws + WS_QM); bf16_t* KM = (bf16_t*)(ws + WS_KM); bf16_t* VM = (bf16_t*)(ws + WS_VM);
    float* XBC = (float*)(ws + WS_XBC); float* CS = (float*)(ws + WS_CS); float* PREV = (float*)(ws + WS_PREV); float* YS = (float*)(ws + WS_YS);
    for (int l = 0; l < DEPTH; ++l) {
        char* wl = ws + WS_W0 + (size_t)l * W_LAYER;
        hipLaunchKernelGGL(k_wt, dim3(DINP / 32, DM / 32), dim3(256), 0, stream, w_in + (size_t)l * DM * DIN, DM, DIN, DINP, (bf16_t*)(wl + W_IN), DM, 0, 0, (const float*)nullptr);
        hipLaunchKernelGGL(k_wt, dim3(DM / 32, DM / 32), dim3(256), 0, stream, w_out + (size_t)l * DM * DM, DM, DM, DM, (bf16_t*)(wl + W_OUT), DM, 0, 0, (const float*)nullptr);
        hipLaunchKernelGGL(k_wt, dim3(DFF / 32, DM / 32), dim3(256), 0, stream, w_up + (size_t)l * DM * DFF, DM, DFF, DFF, (bf16_t*)(wl + W_UP), DM, 0, 0, (const float*)nullptr);
        hipLaunchKernelGGL(k_wt, dim3(DM / 32, DFF / 32), dim3(256), 0, stream, w_down + (size_t)l * DFF * DM, DFF, DM, DM, (bf16_t*)(wl + W_DN), DFF, 0, 0, (const float*)nullptr);
        hipLaunchKernelGGL(k_wt, dim3(384 / 32, 256 / 32), dim3(256), 0, stream, w_uq + (size_t)l * 256 * 384, 256, 384, 384, (bf16_t*)(wl + W_UQ), 256, 0, 0, q_norm_g + l * 256);
        hipLaunchKernelGGL(k_wt, dim3(512 / 32, 128 / 32), dim3(256), 0, stream, w_ukv + (size_t)l * 128 * 512, 128, 512, 512, (bf16_t*)(wl + W_UKV), 128, 0, 0, kv_norm_g + l * 128);
    }
    hipLaunchKernelGGL(k_mod, dim3(2 * 6144 / 256), dim3(256), 0, stream, c, w_ada, b_ada, MOD);
    hipLaunchKernelGGL(k_rope, dim3(T * 16 / 256), dim3(256), 0, stream, pos, COS, SIN);
    hipLaunchKernelGGL(k_norm_mod, dim3(T / 4), dim3(256), 0, stream, x, norm_g, MOD + 0, MOD + 1024, XN);
    for (int l = 0; l < DEPTH; ++l) {
        char* wl = ws + WS_W0 + (size_t)l * W_LAYER; const float* mod = MOD + (size_t)l * 8 * 6144;
        const float lambda_init = (l == 0) ? 0.2f : (float)(0.8 - 0.6 * 0.7408182206817179);
        const float* xin = (l == 0) ? x : out; const int base = 1 + l * PH_PER_LAYER;
        launch_mega(a, base + PH_IN, base + PH_IN + 1, stream);
        hipLaunchKernelGGL(k_mla_q_ref, dim3(T), dim3(384), 0, stream, PROJ, (const bf16_t*)(wl + W_UQ), COS, SIN, QM);
        hipLaunchKernelGGL(k_mla_kv_ref, dim3(T), dim3(512), 0, stream, PROJ, (const bf16_t*)(wl + W_UKV), COS, SIN, KM, VM);
        launch_mega(a, base + PH_MIX, base + PH_MIX + 1, stream);
        hipLaunchKernelGGL(k_conv_ref, dim3(T / 64), dim3(256), 0, stream, PROJ, DTF, conv_w + (size_t)l * 4 * 768, conv_b + l * 768, dt_bias + l * 8, a_log + l * 8, XBC, DTV, ACS);
        hipLaunchKernelGGL(k_cs_ref, dim3(T / 64, 8), dim3(256), 0, stream, XBC, DTV, ACS, CS);
        hipLaunchKernelGGL(k_scan_ref, dim3(NB * 8 * 4096 / 256), dim3(256), 0, stream, CS, ACS, PREV);
        hipLaunchKernelGGL(k_y_ref, dim3(T / 64, 8), dim3(256), 0, stream, XBC, DTV, ACS, PREV, d_skip + l * 8, YS);
        hipLaunchKernelGGL(k_gate_ref, dim3(T * 2 / 4), dim3(256), 0, stream, YS, PROJ, ssm_norm_g + l * 512, Y);
        launch_mega(a, base + PH_OUT, base + PH_OUT + 1, stream);
        hipLaunchKernelGGL(k_resnorm, dim3(T / 4), dim3(256), 0, stream, xin, YO, norm_g + (l * 4 + 1) * DM, mod + 2048, out, norm_g + (l * 4 + 2) * DM, mod + 3072, mod + 4096, XN);
        launch_mega(a, base + PH_UP, base + PH_UP + 1, stream);
        launch_mega(a, base + PH_DN, base + PH_DN + 1, stream);
        if (l + 1 < DEPTH) { const float* modn = MOD + (size_t)(l + 1) * 8 * 6144;
            hipLaunchKernelGGL(k_resnorm, dim3(T / 4), dim3(256), 0, stream, out, YO, norm_g + (l * 4 + 3) * DM, mod + 5120, out, norm_g + ((l + 1) * 4 + 0) * DM, modn + 0, modn + 1024, XN);
        } else {
            hipLaunchKernelGGL(k_resnorm, dim3(T / 4), dim3(256), 0, stream, out, YO, norm_g + (l * 4 + 3) * DM, mod + 5120, out, (const float*)nullptr, (const float*)nullptr, (const float*)nullptr, (bf16_t*)nullptr);
        }
    }
}
```

```cpp
#include <hip/hip_runtime.h>
#include <cstdint>
#include <cstdio>

typedef unsigned short bf16_t;
typedef short bf16x8 __attribute__((ext_vector_type(8)));
typedef float f32x4 __attribute__((ext_vector_type(4)));

constexpr int NB = 8, SEQ = 4096, DM = 1024, T = NB * SEQ, DEPTH = 2;
constexpr int DIN = 2472, DINP = 2560, DFF = 4096;
constexpr int C_AQ = 0, C_AK = 256, C_AV = 512, C_CQ = 768, C_CKV = 1024, C_KR = 1152, C_Z = 1184, C_XBC = 1696, C_DT = 2464;
constexpr int NCH = SEQ / 64;
constexpr int NWAVES = 8;
constexpr float LOG2E = 1.4426950408889634f;
constexpr float DA_SCALE = 0.17677669529663687f * LOG2E;
constexpr float MLA_SCALE = 0.10206207261596577f * LOG2E;

constexpr size_t MiB = 1u << 20;
constexpr size_t WS_CTL = 0;
constexpr size_t WS_MOD = 1 * MiB;
constexpr size_t WS_COS = 2 * MiB;
constexpr size_t WS_SIN = 4 * MiB;
constexpr size_t WS_DTF = 6 * MiB;
constexpr size_t WS_ACS = 7 * MiB;
constexpr size_t WS_DTV = 8 * MiB;
constexpr size_t WS_RSS = 9 * MiB;
constexpr size_t WS_W0 = 10 * MiB;
constexpr size_t W_IN = 0, W_OUT = 5 * MiB, W_UP = 7 * MiB, W_DN = 15 * MiB, W_U = 23 * MiB  , W_LAYER = 24 * MiB;
constexpr size_t WS_XN = 58 * MiB;
constexpr size_t WS_Y = WS_XN;
constexpr size_t WS_YO = 122 * MiB;
constexpr size_t WS_CS = 122 * MiB;
constexpr size_t WS_YS = 122 * MiB;
constexpr size_t WS_PREV = 186 * MiB;
constexpr size_t WS_CSB = WS_CS;
constexpr size_t WS_PRVB = WS_CS + 32 * MiB;
constexpr size_t WS_CDEC = WS_ACS;
constexpr size_t WS_R = 250 * MiB;
constexpr size_t WS_H = WS_R;
constexpr size_t WS_PROJ = WS_R;
constexpr size_t WS_QM = WS_R + 160 * MiB;
constexpr size_t WS_KM = WS_R + 184 * MiB;
constexpr size_t WS_VM = WS_R + 208 * MiB;
constexpr size_t WS_XBC = WS_R + 160 * MiB;
constexpr size_t WS_END = 506 * MiB;

__device__ __forceinline__ float bf2f(bf16_t v) { return __uint_as_float((unsigned)v << 16); }
__device__ __forceinline__ bf16_t f2bf(float f) { unsigned u = __float_as_uint(f); return (bf16_t)((u + 0x7fffu + ((u >> 16) & 1u)) >> 16); }
__device__ __forceinline__ float wave_sum(float v) {
#pragma unroll
    for (int o = 1; o < 64; o <<= 1) v += __shfl_xor(v, o);
    return v;
}
__device__ __forceinline__ float silu_f(float v) { return v / (1.f + __expf(-v)); }

__global__ void k_wt(const float* __restrict__ W, int K, int N, int Npad, bf16_t* __restrict__ Wt, int ldk, int row_off, int k_off, const float* __restrict__ g) {
    __shared__ float tile[32][33];
    const int n0 = blockIdx.x * 32, k0 = blockIdx.y * 32, tx = threadIdx.x & 31, ty = threadIdx.x >> 5;
    for (int i = ty; i < 32; i += 8) { const int k = k0 + i, n = n0 + tx; float v = (n < N) ? W[(size_t)k * N + n] : 0.f; if (g) v *= g[k]; tile[i][tx] = v; }
    __syncthreads();
    for (int i = ty; i < 32; i += 8) { const int n = n0 + i, k = k0 + tx; Wt[(size_t)(row_off + n) * ldk + k_off + k] = f2bf(tile[tx][i]); }
}
__global__ void k_zero16(bf16_t* p, size_t n) { size_t i = (size_t)blockIdx.x * blockDim.x + threadIdx.x; if (i < n) p[i] = 0; }

__global__ void k_mod(const float* __restrict__ c, const float* __restrict__ w_ada, const float* __restrict__ b_ada, float* __restrict__ MOD) {
    __shared__ float sc[8 * 1024];
    for (int i = threadIdx.x; i < 8 * 1024; i += blockDim.x) sc[i] = silu_f(c[i]);
    __syncthreads();
    const int gid = blockIdx.x * blockDim.x + threadIdx.x; if (gid >= 2 * 6144) return;
    const int l = gid / 6144, n = gid % 6144;
    float acc[8];
#pragma unroll
    for (int b = 0; b < 8; ++b) acc[b] = 0.f;
    const float* w = w_ada + (size_t)l * 1024 * 6144 + n;
    for (int k = 0; k < 1024; ++k) { const float wv = w[(size_t)k * 6144];
#pragma unroll
        for (int b = 0; b < 8; ++b) acc[b] += sc[b * 1024 + k] * wv; }
#pragma unroll
    for (int b = 0; b < 8; ++b) MOD[(size_t)(l * 8 + b) * 6144 + n] = acc[b] + b_ada[l * 6144 + n];
}
__global__ void k_rope(const int* __restrict__ pos, float* __restrict__ COS, float* __restrict__ SIN) {
    const int gid = blockIdx.x * blockDim.x + threadIdx.x; if (gid >= T * 16) return;
    const int t = gid >> 4, i = gid & 15;
    const float inv = (float)pow(10000.0, -(double)i / 16.0);
    const float ang = (float)pos[t] * inv;
    COS[gid] = (float)cos((double)ang); SIN[gid] = (float)sin((double)ang);
}

__global__ void k_norm_mod(const float* __restrict__ x, const float* __restrict__ g, const float* __restrict__ sh, const float* __restrict__ sc, bf16_t* __restrict__ XN) {
    const int row = blockIdx.x * 4 + (threadIdx.x >> 6), lane = threadIdx.x & 63, b = row / SEQ;
    const f32x4* xr = (const f32x4*)(x + (size_t)row * DM);
    f32x4 v[4]; float ss = 0.f;
#pragma unroll
    for (int j = 0; j < 4; ++j) { v[j] = xr[lane + 64 * j]; ss += v[j].x * v[j].x + v[j].y * v[j].y + v[j].z * v[j].z + v[j].w * v[j].w; }
    const float rstd = 1.0f / sqrtf(wave_sum(ss) * (1.f / DM) + 1e-6f);
#pragma unroll
    for (int j = 0; j < 4; ++j) { const int col = (lane + 64 * j) * 4;
        const f32x4 gv = *(const f32x4*)(g + col), shv = *(const f32x4*)(sh + (size_t)b * 6144 + col), scv = *(const f32x4*)(sc + (size_t)b * 6144 + col);
        bf16_t* o = XN + (size_t)row * DM + col;
        o[0] = f2bf(v[j].x * rstd * gv.x * (1.f + scv.x) + shv.x); o[1] = f2bf(v[j].y * rstd * gv.y * (1.f + scv.y) + shv.y);
        o[2] = f2bf(v[j].z * rstd * gv.z * (1.f + scv.z) + shv.z); o[3] = f2bf(v[j].w * rstd * gv.w * (1.f + scv.w) + shv.w); }
}
__global__ void k_resnorm(const float* xi, const float* __restrict__ yo, const float* __restrict__ gw, const float* __restrict__ gate, float* xo,
                          const float* __restrict__ g2, const float* __restrict__ sh, const float* __restrict__ sc, bf16_t* __restrict__ XN) {
    const int row = blockIdx.x * 4 + (threadIdx.x >> 6), lane = threadIdx.x & 63, b = row / SEQ;
    const f32x4* yr = (const f32x4*)(yo + (size_t)row * DM); const f32x4* xr = (const f32x4*)(xi + (size_t)row * DM);
    f32x4 v[4]; float ss = 0.f;
#pragma unroll
    for (int j = 0; j < 4; ++j) { v[j] = yr[lane + 64 * j]; ss += v[j].x * v[j].x + v[j].y * v[j].y + v[j].z * v[j].z + v[j].w * v[j].w; }
    const float rstd = 1.0f / sqrtf(wave_sum(ss) * (1.f / DM) + 1e-6f);
    float s2 = 0.f;
#pragma unroll
    for (int j = 0; j < 4; ++j) { const int col = (lane + 64 * j) * 4;
        const f32x4 gv = *(const f32x4*)(gw + col), gt = *(const f32x4*)(gate + (size_t)b * 6144 + col), xv = xr[lane + 64 * j];
        v[j].x = xv.x + gt.x * (v[j].x * rstd * gv.x); v[j].y = xv.y + gt.y * (v[j].y * rstd * gv.y); v[j].z = xv.z + gt.z * (v[j].z * rstd * gv.z); v[j].w = xv.w + gt.w * (v[j].w * rstd * gv.w);
        *(f32x4*)(xo + (size_t)row * DM + col) = v[j];
        s2 += v[j].x * v[j].x + v[j].y * v[j].y + v[j].z * v[j].z + v[j].w * v[j].w; }
    if (XN) {
        const float r2 = 1.0f / sqrtf(wave_sum(s2) * (1.f / DM) + 1e-6f);
#pragma unroll
        for (int j = 0; j < 4; ++j) { const int col = (lane + 64 * j) * 4;
            const f32x4 gv = *(const f32x4*)(g2 + col), shv = *(const f32x4*)(sh + (size_t)b * 6144 + col), scv = *(const f32x4*)(sc + (size_t)b * 6144 + col);
            bf16_t* o = XN + (size_t)row * DM + col;
            o[0] = f2bf(v[j].x * r2 * gv.x * (1.f + scv.x) + shv.x); o[1] = f2bf(v[j].y * r2 * gv.y * (1.f + scv.y) + shv.y);
            o[2] = f2bf(v[j].z * r2 * gv.z * (1.f + scv.z) + shv.z); o[3] = f2bf(v[j].w * r2 * gv.w * (1.f + scv.w) + shv.w); }
    }
}

template <int MODE>
__global__ void __launch_bounds__(256) k_gemm_ref(const bf16_t* __restrict__ A, int lda, const bf16_t* __restrict__ Bt, int ldb, int K, bf16_t* __restrict__ O, float* __restrict__ F, int ldc, float* __restrict__ DTF) {
    const int wave = threadIdx.x >> 6, lane = threadIdx.x & 63, r16 = lane & 15, q4 = lane >> 4;
    const int m0 = blockIdx.y * 64 + (wave >> 1) * 32, n0 = blockIdx.x * 64 + (wave & 1) * 32;
    f32x4 acc[2][2];
#pragma unroll
    for (int i = 0; i < 2; ++i)
#pragma unroll
        for (int j = 0; j < 2; ++j) acc[i][j] = (f32x4){0.f, 0.f, 0.f, 0.f};
    const bf16_t* a0 = A + (size_t)(m0 + r16) * lda + q4 * 8; const bf16_t* a1 = a0 + (size_t)16 * lda;
    const bf16_t* b0 = Bt + (size_t)(n0 + r16) * ldb + q4 * 8; const bf16_t* b1 = b0 + (size_t)16 * ldb;
    for (int k = 0; k < K; k += 32) {
        const bf16x8 fa0 = *(const bf16x8*)(a0 + k), fa1 = *(const bf16x8*)(a1 + k), fb0 = *(const bf16x8*)(b0 + k), fb1 = *(const bf16x8*)(b1 + k);
        acc[0][0] = __builtin_amdgcn_mfma_f32_16x16x32_bf16(fa0, fb0, acc[0][0], 0, 0, 0);
        acc[0][1] = __builtin_amdgcn_mfma_f32_16x16x32_bf16(fa0, fb1, acc[0][1], 0, 0, 0);
        acc[1][0] = __builtin_amdgcn_mfma_f32_16x16x32_bf16(fa1, fb0, acc[1][0], 0, 0, 0);
        acc[1][1] = __builtin_amdgcn_mfma_f32_16x16x32_bf16(fa1, fb1, acc[1][1], 0, 0, 0);
    }
#pragma unroll
    for (int i = 0; i < 2; ++i)
#pragma unroll
        for (int j = 0; j < 2; ++j)
#pragma unroll
            for (int r = 0; r < 4; ++r) {
                const int m = m0 + 16 * i + q4 * 4 + r, n = n0 + 16 * j + r16; float v = acc[i][j][r];
                if (MODE == 0) { if (n < 256) v *= DA_SCALE; O[(size_t)m * ldc + n] = f2bf(v); if (n >= C_DT && n < C_DT + 8) DTF[(size_t)m * 8 + (n - C_DT)] = v; }
                else if (MODE == 1) F[(size_t)m * ldc + n] = v;
                else { v = v > 0.f ? v * v : 0.f; O[(size_t)m * ldc + n] = f2bf(v); }
            }
}

__global__ void k_mla_q_ref(const bf16_t* __restrict__ PROJ, const bf16_t* __restrict__ WUQ  , const float* __restrict__ COS, const float* __restrict__ SIN, bf16_t* __restrict__ QM) {
    const int t = blockIdx.x, n = threadIdx.x;
    __shared__ float cq[256]; __shared__ float red[8]; __shared__ float rstd_s;
    if (n < 256) cq[n] = bf2f(PROJ[(size_t)t * DINP + C_CQ + n]);
    __syncthreads();
    if (n < 64) { float s = 0.f; for (int k = n; k < 256; k += 64) s += cq[k] * cq[k]; s = wave_sum(s); if (n == 0) rstd_s = 1.0f / sqrtf(s * (1.f / 256.f) + 1e-6f); }
    __syncthreads();
    const float rstd = rstd_s;
    const int h = n / 96, j = n % 96;
    if (j >= 80) return;
    float d0 = 0.f; { const bf16_t* w = WUQ + (size_t)n * 384; for (int k = 0; k < 256; ++k) d0 += cq[k] * bf2f(w[k]); } d0 *= rstd;
    if (j < 64) { QM[(size_t)t * 384 + n] = f2bf(d0 * MLA_SCALE); return; }
    float d1 = 0.f; { const bf16_t* w = WUQ + (size_t)(n + 16) * 384; for (int k = 0; k < 256; ++k) d1 += cq[k] * bf2f(w[k]); } d1 *= rstd;
    const int i = j - 64; const float cs = COS[(size_t)t * 16 + i], sn = SIN[(size_t)t * 16 + i];
    QM[(size_t)t * 384 + h * 96 + 64 + i] = f2bf((d0 * cs - d1 * sn) * MLA_SCALE);
    QM[(size_t)t * 384 + h * 96 + 80 + i] = f2bf((d0 * sn + d1 * cs) * MLA_SCALE);
}
__global__ void k_mla_kv_ref(const bf16_t* __restrict__ PROJ, const bf16_t* __restrict__ WUKV  , const float* __restrict__ COS, const float* __restrict__ SIN, bf16_t* __restrict__ KM, bf16_t* __restrict__ VM) {
    const int t = blockIdx.x, n = threadIdx.x;
    __shared__ float ck[128]; __shared__ float rstd_s;
    if (n < 128) ck[n] = bf2f(PROJ[(size_t)t * DINP + C_CKV + n]);
    __syncthreads();
    if (n < 64) { float s = ck[n] * ck[n] + ck[n + 64] * ck[n + 64]; s = wave_sum(s); if (n == 0) rstd_s = 1.0f / sqrtf(s * (1.f / 128.f) + 1e-6f); }
    __syncthreads();
    float d = 0.f; { const bf16_t* w = WUKV + (size_t)(384 + n) * 384 + 256; for (int k = 0; k < 128; ++k) d += ck[k] * bf2f(w[k]); } d *= rstd_s;
    const int h = n >> 7, j = n & 127;
    if (j < 64) KM[(size_t)t * 384 + h * 96 + j] = f2bf(d); else VM[(size_t)t * 256 + h * 64 + (j - 64)] = f2bf(d);
    if (n < 16) { const float t1 = bf2f(PROJ[(size_t)t * DINP + C_KR + n]), t2 = bf2f(PROJ[(size_t)t * DINP + C_KR + 16 + n]); const float cs = COS[(size_t)t * 16 + n], sn = SIN[(size_t)t * 16 + n];
        const bf16_t r1 = f2bf(t1 * cs - t2 * sn), r2 = f2bf(t1 * sn + t2 * cs);
        for (int hh = 0; hh < 4; ++hh) { KM[(size_t)t * 384 + hh * 96 + 64 + n] = r1; KM[(size_t)t * 384 + hh * 96 + 80 + n] = r2; } }
}

template <int DQK>
__device__ __forceinline__ void attn_row(const bf16_t* __restrict__ qp, const bf16_t* __restrict__ kbase, int ldk, const bf16_t* __restrict__ vbase, int ldv, int nkeys, float (&o)[32], float& l_out) {
    float q[DQK];
#pragma unroll
    for (int d = 0; d < DQK; ++d) q[d] = bf2f(qp[d]);
    float m = -INFINITY, l = 0.f;
#pragma unroll
    for (int e = 0; e < 32; ++e) o[e] = 0.f;
    for (int j = 0; j < nkeys; ++j) {
        const bf16_t* kp = kbase + (size_t)j * ldk; const bf16_t* vp = vbase + (size_t)j * ldv;
        float s = 0.f;
#pragma unroll
        for (int d = 0; d < DQK; ++d) s += q[d] * bf2f(kp[d]);
        const float mn = fmaxf(m, s), a = exp2f(m - mn), p = exp2f(s - mn);
        l = l * a + p; m = mn;
#pragma unroll
        for (int e = 0; e < 32; ++e) o[e] = o[e] * a + p * bf2f(vp[e]);
    }
    l_out = l;
}
__global__ void __launch_bounds__(128) k_da_ref(const bf16_t* __restrict__ PROJ, bf16_t* __restrict__ Y, const float* __restrict__ lam_p, const float* __restrict__ subln_g, float lambda_init) {
    const int ck = blockIdx.x, h = blockIdx.y, row = threadIdx.x & 63, half = threadIdx.x >> 6;
    const int b = ck / NCH, c = ck % NCH, t = ck * 64 + row, nkeys = (c + 1) * 64;
    const size_t kb = (size_t)b * SEQ * DINP;
    float ls0 = 0.f, ls1 = 0.f;
    for (int i = 0; i < 32; ++i) { ls0 += lam_p[i] * lam_p[32 + i]; ls1 += lam_p[64 + i] * lam_p[96 + i]; }
    const float lam = __expf(ls0) - __expf(ls1) + lambda_init;
    float o1[32], o2[32], l1, l2;
    attn_row<32>(PROJ + (size_t)t * DINP + C_AQ + h * 64, PROJ + kb + C_AK + h * 64, DINP, PROJ + kb + C_AV + h * 64 + half * 32, DINP, nkeys, o1, l1);
    attn_row<32>(PROJ + (size_t)t * DINP + C_AQ + h * 64 + 32, PROJ + kb + C_AK + h * 64 + 32, DINP, PROJ + kb + C_AV + h * 64 + half * 32, DINP, nkeys, o2, l2);
    float ss = 0.f; const float i1 = 1.f / l1, i2 = lam / l2;
#pragma unroll
    for (int e = 0; e < 32; ++e) { o1[e] = o1[e] * i1 - o2[e] * i2; ss += o1[e] * o1[e]; }
    __shared__ float part[128];
    part[threadIdx.x] = ss; __syncthreads();
    const float tot = part[row] + part[64 + row];
    const float rstd = 1.0f / sqrtf(tot * (1.f / 64.f) + 1e-5f) * (1.f - lambda_init);
#pragma unroll
    for (int e = 0; e < 32; ++e) Y[(size_t)t * DM + h * 64 + half * 32 + e] = f2bf(o1[e] * rstd * subln_g[half * 32 + e]);
}
__global__ void __launch_bounds__(128) k_mla_ref(const bf16_t* __restrict__ QM, const bf16_t* __restrict__ KM, const bf16_t* __restrict__ VM, bf16_t* __restrict__ Y) {
    const int ck = blockIdx.x, h = blockIdx.y, row = threadIdx.x & 63, half = threadIdx.x >> 6;
    const int b = ck / NCH, c = ck % NCH, t = ck * 64 + row, nkeys = (c + 1) * 64;
    float o[32], l;
    attn_row<96>(QM + (size_t)t * 384 + h * 96, KM + (size_t)b * SEQ * 384 + h * 96, 384, VM + (size_t)b * SEQ * 256 + h * 64 + half * 32, 256, nkeys, o, l);
    const float il = 1.f / l;
#pragma unroll
    for (int e = 0; e < 32; ++e) Y[(size_t)t * DM + 256 + h * 64 + half * 32 + e] = f2bf(o[e] * il);
}

__global__ void __launch_bounds__(256) k_conv_ref(const bf16_t* __restrict__ PROJ, const float* __restrict__ DTF, const float* __restrict__ conv_w, const float* __restrict__ conv_b,
                                                  const float* __restrict__ dt_bias, const float* __restrict__ a_log, float* __restrict__ XBC, float* __restrict__ DTV, float* __restrict__ ACS) {
    const int ck = blockIdx.x, c = ck % NCH, t0 = ck * 64;
    for (int idx = threadIdx.x; idx < 64 * 768; idx += 256) {
        const int l = idx / 768, ch = idx % 768, t = t0 + l, s = c * 64 + l;
        float acc = conv_b[ch];
#pragma unroll
        for (int w = 0; w < 4; ++w) { const int sp = s - 3 + w; if (sp >= 0) acc += conv_w[w * 768 + ch] * bf2f(PROJ[(size_t)(t - 3 + w) * DINP + C_XBC + ch]); }
        XBC[(size_t)t * 768 + ch] = silu_f(acc);
    }
    if (threadIdx.x < 8) { const int h = threadIdx.x; const float a = -__expf(a_log[h]); float cs = 0.f;
        for (int l = 0; l < 64; ++l) { const float r = DTF[(size_t)(t0 + l) * 8 + h] + dt_bias[h]; const float dt = r > 20.f ? r : log1pf(__expf(r)); cs += dt * a; DTV[(size_t)(t0 + l) * 8 + h] = dt; ACS[(size_t)(t0 + l) * 8 + h] = cs; } }
}
__global__ void __launch_bounds__(256) k_cs_ref(const float* __restrict__ XBC, const float* __restrict__ DTV, const float* __restrict__ ACS, float* __restrict__ CS) {
    const int ck = blockIdx.x, h = blockIdx.y, g = h >> 2, t0 = ck * 64;
    __shared__ float sB[64][64]; __shared__ float sX[64][65];
    for (int idx = threadIdx.x; idx < 4096; idx += 256) { const int l = idx >> 6, j = idx & 63; const size_t r = (size_t)(t0 + l) * 768;
        sB[l][j] = XBC[r + 512 + g * 64 + j];
        sX[l][j] = XBC[r + h * 64 + j] * DTV[(size_t)(t0 + l) * 8 + h] * __expf(ACS[(size_t)(t0 + 63) * 8 + h] - ACS[(size_t)(t0 + l) * 8 + h]); }
    __syncthreads();
    const int p = threadIdx.x >> 2, nb = (threadIdx.x & 3) * 16;
    float acc[16];
#pragma unroll
    for (int i = 0; i < 16; ++i) acc[i] = 0.f;
    for (int l = 0; l < 64; ++l) { const float xv = sX[l][p];
#pragma unroll
        for (int i = 0; i < 16; ++i) acc[i] += xv * sB[l][nb + i]; }
    float* o = CS + ((size_t)(ck * 8 + h) * 64 + p) * 64 + nb;
#pragma unroll
    for (int i = 0; i < 16; ++i) o[i] = acc[i];
}
__global__ void k_scan_ref(const float* __restrict__ CS, const float* __restrict__ ACS, float* __restrict__ PREV) {
    const int gid = blockIdx.x * blockDim.x + threadIdx.x;
    const int e = gid & 4095, h = (gid >> 12) & 7, b = gid >> 15;
    float st = 0.f;
    for (int c = 0; c < NCH; ++c) { const int ck = b * NCH + c; const size_t off = (size_t)(ck * 8 + h) * 4096 + e;
        PREV[off] = st; st = st * __expf(ACS[(size_t)(ck * 64 + 63) * 8 + h]) + CS[off]; }
}
__global__ void __launch_bounds__(256) k_y_ref(const float* __restrict__ XBC, const float* __restrict__ DTV, const float* __restrict__ ACS, const float* __restrict__ PREV, const float* __restrict__ d_skip, float* __restrict__ YS) {
    const int ck = blockIdx.x, h = blockIdx.y, g = h >> 2, t0 = ck * 64;
    __shared__ float sG[64][65]; __shared__ float sX[64][64]; __shared__ float sP[64][65];
    for (int idx = threadIdx.x; idx < 4096; idx += 256) { const int l = idx >> 6, s = idx & 63; float v = 0.f;
        if (s <= l) { const float* cp = XBC + (size_t)(t0 + l) * 768 + 640 + g * 64; const float* bp = XBC + (size_t)(t0 + s) * 768 + 512 + g * 64;
            for (int n = 0; n < 64; ++n) v += cp[n] * bp[n];
            v *= __expf(ACS[(size_t)(t0 + l) * 8 + h] - ACS[(size_t)(t0 + s) * 8 + h]); }
        sG[l][s] = v;
        sX[l][s] = XBC[(size_t)(t0 + l) * 768 + h * 64 + s] * DTV[(size_t)(t0 + l) * 8 + h];
        sP[l][s] = PREV[((size_t)(ck * 8 + h) * 64 + l) * 64 + s]; }
    __syncthreads();
    const int l = threadIdx.x >> 2, pb = (threadIdx.x & 3) * 16;
    float acc[16];
#pragma unroll
    for (int i = 0; i < 16; ++i) acc[i] = 0.f;
    for (int s = 0; s <= l; ++s) { const float gv = sG[l][s];
#pragma unroll
        for (int i = 0; i < 16; ++i) acc[i] += gv * sX[s][pb + i]; }
    const float* cp = XBC + (size_t)(t0 + l) * 768 + 640 + g * 64; const float el = __expf(ACS[(size_t)(t0 + l) * 8 + h]);
    float off[16];
#pragma unroll
    for (int i = 0; i < 16; ++i) off[i] = 0.f;
    for (int n = 0; n < 64; ++n) { const float cv = cp[n];
#pragma unroll
        for (int i = 0; i < 16; ++i) off[i] += cv * sP[pb + i][n]; }
    const float dsk = d_skip[h];
#pragma unroll
    for (int i = 0; i < 16; ++i) YS[(size_t)(t0 + l) * 512 + h * 64 + pb + i] = acc[i] + off[i] * el + XBC[(size_t)(t0 + l) * 768 + h * 64 + pb + i] * dsk;
}
__global__ void k_gate_ref(const float* __restrict__ YS, const bf16_t* __restrict__ PROJ, const float* __restrict__ norm_g, bf16_t* __restrict__ Y) {
    const int wid = blockIdx.x * 4 + (threadIdx.x >> 6), lane = threadIdx.x & 63, t = wid >> 1, g = wid & 1;
    float v[4]; float ss = 0.f;
#pragma unroll
    for (int i = 0; i < 4; ++i) { const int ch = g * 256 + lane * 4 + i; const float z = bf2f(PROJ[(size_t)t * DINP + C_Z + ch]); v[i] = YS[(size_t)t * 512 + ch] * silu_f(z); ss += v[i] * v[i]; }
    const float rstd = 1.0f / sqrtf(wave_sum(ss) * (1.f / 256.f) + 1e-6f);
#pragma unroll
    for (int i = 0; i < 4; ++i) { const int ch = g * 256 + lane * 4 + i; Y[(size_t)t * DM + 512 + ch] = f2bf(v[i] * rstd * norm_g[ch]); }
}


namespace pg8 {
#define PG8_LAS __attribute__((address_space(3)))
typedef unsigned short bf16_t;
typedef short bf16x8 __attribute__((ext_vector_type(8)));
typedef float f32x4 __attribute__((ext_vector_type(4)));
typedef unsigned u32x4 __attribute__((ext_vector_type(4)));
constexpr int BM = 256, BK = 64, HALF = 128, HTB = HALF * BK * 2  , STAGE_BYTES = 8 * HTB, NXCD = 8, WGM = 8;

__host__ __device__ __forceinline__ int lds_byte(int r, int c) { const int st = (r >> 4) * 2 + (c >> 5), rr = r & 15, cc = c & 31, ob = rr * 64 + cc * 2; return st * 1024 + (ob ^ (((ob >> 9) & 1) << 5)); }
__host__ __device__ __forceinline__ void stage_rc(int b, int& R, int& C) { const int st = b / 1024, sb = b % 1024, swz = sb ^ (((sb >> 9) & 1) << 5); R = (st >> 1) * 16 + swz / 64; C = (st & 1) * 32 + (swz % 64) / 2; }
__host__ __device__ __forceinline__ int perm32(int rho) { const int n = rho >> 4, i = rho & 15; return 8 * (i >> 2) + 4 * n + (i & 3); }

struct Unit { int pm, pn; };
struct Gemm { const bf16_t* A; const bf16_t* Bt; int M, N, K, lda, ldb; };

struct StaticOrder {
    int nM, nN, nwg, G, c;
    __host__ __device__ void init(int M, int N, int G_, int c_) { nM = M / BM; nN = N / BM; nwg = nM * nN; G = G_; c = c_; }
    __host__ __device__ bool next(int i, Unit& u) const {
        const long L = (long)i * G + c; if (L >= nwg) return false;
        int wgid = (int)L; { const int q = nwg / NXCD, r = nwg % NXCD, xcd = wgid % NXCD, off = wgid / NXCD; wgid = (xcd < r ? xcd * (q + 1) : r * (q + 1) + (xcd - r) * q) + off; }
        const int nig = WGM * nN, gid = wgid / nig, fm = gid * WGM, gsz = (nM - fm) < WGM ? (nM - fm) : WGM;
        u.pm = fm + ((wgid % nig) % gsz); u.pn = (wgid % nig) / gsz; return true;
    }
    __device__ __forceinline__ void a_ready(const Unit&) const {}
    __device__ __forceinline__ void done(const Unit&) const {}
};
__device__ __forceinline__ unsigned cvt_pk_bf16(float lo, float hi) { unsigned r; asm volatile("v_cvt_pk_bf16_f32 %0, %1, %2" : "=v"(r) : "v"(lo), "v"(hi)); return r; }
typedef float f32x2 __attribute__((ext_vector_type(2)));
template <class Epi, class Sched, bool ALIGN_EPI = false, bool SP2 = false>
__device__ __forceinline__ void gemm_phase(PG8_LAS unsigned char* lds, const Gemm g, const Sched& S, const Epi& E) {
    int tid_ = threadIdx.x; asm volatile("" : "+v"(tid_));
    const int tid = tid_, wid = __builtin_amdgcn_readfirstlane(tid >> 6), lane = tid & 63, wr = wid >> 2, wc = wid & 3, fr = lane & 15, fq = lane >> 4;
    const int K = g.K, nt = K / BK;
    unsigned voffA[2], voffB[2];
#pragma unroll
    for (int i = 0; i < 2; ++i) { int R, C; stage_rc(tid * 16 + i * 8192, R, C); const int Rb = Epi::PERM ? ((R & ~31) + perm32(R & 31)) : R;
        voffA[i] = (unsigned)(R * g.lda + C) * 2u; voffB[i] = (unsigned)(Rb * g.ldb + C) * 2u; }
    const unsigned kstep = (unsigned)(BK * 2);
    const unsigned hstepA = (unsigned)HALF * g.lda * 2u, hstepB = (unsigned)HALF * g.ldb * 2u;
    const unsigned tstepA = 2u * hstepA, tstepB = 2u * hstepB;
    const unsigned ldsw = (unsigned)wid * 1024u;
    const int aoff = lds_byte(wr * 64 + fr, fq * 8), boff = lds_byte(wc * 32 + fr, fq * 8);
#define PG8_SA(b, h) (((b) * 2 + (h)) * HTB)
#define PG8_SB(b, h) ((4 + (b) * 2 + (h)) * HTB)
#define PG8_STAGEX(bufoff, uoff, voff, gptr) do { _Pragma("unroll") for (int _i = 0; _i < 2; ++_i) \
        __builtin_amdgcn_global_load_lds((const unsigned*)((gptr) + (size_t)((unsigned)(uoff) + (voff)[_i])), (PG8_LAS unsigned*)(lds + (bufoff) + ldsw + _i * 8192), 16, 0, 0); } while (0)
#define PG8_LDA(dst, b, h) do { _Pragma("unroll") for (int m = 0; m < 4; ++m) _Pragma("unroll") for (int k = 0; k < 2; ++k) dst[m][k] = *(const PG8_LAS bf16x8*)(lds + PG8_SA(b, h) + aoff + m * 2048 + k * 1024); } while (0)
#define PG8_LDB(dst, b, h) do { _Pragma("unroll") for (int n = 0; n < 2; ++n) _Pragma("unroll") for (int k = 0; k < 2; ++k) dst[n][k] = *(const PG8_LAS bf16x8*)(lds + PG8_SB(b, h) + boff + n * 2048 + k * 1024); } while (0)
#define PG8_MMA(ai, bj, At, Bt) do { __builtin_amdgcn_s_setprio(1); _Pragma("unroll") for (int m = 0; m < 4; ++m) _Pragma("unroll") for (int n = 0; n < 2; ++n) _Pragma("unroll") for (int k = 0; k < 2; ++k) \
        acc[ai][bj][m][n] = __builtin_amdgcn_mfma_f32_16x16x32_bf16(Bt[n][k], At[m][k], acc[ai][bj][m][n], 0, 0, 0); __builtin_amdgcn_s_setprio(0); } while (0)
#define PG8_WAIT_V(n) asm volatile("s_waitcnt vmcnt(" #n ")" ::: "memory")
#define PG8_WAIT_L(n) asm volatile("s_waitcnt lgkmcnt(" #n ")" ::: "memory")
#define PG8_BAR __builtin_amdgcn_s_barrier()
#define PG8_SCHED __builtin_amdgcn_sched_barrier(0)
    Unit cur, nxt; int ui = 0;
    if (!S.next(0, cur)) return;
    f32x4 acc[2][2][4][2];
#pragma unroll
    for (int a = 0; a < 2; ++a)
#pragma unroll
        for (int b = 0; b < 2; ++b)
#pragma unroll
            for (int m = 0; m < 4; ++m)
#pragma unroll
                for (int n = 0; n < 2; ++n) acc[a][b][m][n] = (f32x4){0.f, 0.f, 0.f, 0.f};
    bf16x8 At[4][2], B0[2][2], B1[2][2];
    const char* const gA = (const char*)g.A; const char* const gB = (const char*)g.Bt;
    unsigned cA = (unsigned)cur.pm * tstepA, cB = (unsigned)cur.pn * tstepB;
    S.a_ready(cur);
    if constexpr (SP2) {
        PG8_STAGEX(PG8_SB(0, 0), cB, voffB, gB); PG8_STAGEX(PG8_SB(0, 1), cB + hstepB, voffB, gB); PG8_STAGEX(PG8_SA(0, 0), cA, voffA, gA); PG8_STAGEX(PG8_SA(0, 1), cA + hstepA, voffA, gA);
        if (wr == 1) PG8_BAR;
        PG8_WAIT_V(2); PG8_BAR;
        PG8_STAGEX(PG8_SB(1, 0), cB + kstep, voffB, gB); PG8_STAGEX(PG8_SA(1, 0), cA + kstep, voffA, gA); PG8_STAGEX(PG8_SB(1, 1), cB + hstepB + kstep, voffB, gB);
        PG8_WAIT_V(6); PG8_BAR;
    } else {
        PG8_STAGEX(PG8_SB(0, 0), cB, voffB, gB); PG8_STAGEX(PG8_SA(0, 0), cA, voffA, gA); PG8_STAGEX(PG8_SB(0, 1), cB + hstepB, voffB, gB); PG8_STAGEX(PG8_SA(0, 1), cA + hstepA, voffA, gA);
        if (wr == 1) PG8_BAR;
        PG8_WAIT_V(4); PG8_BAR;
        PG8_STAGEX(PG8_SB(1, 0), cB + kstep, voffB, gB); PG8_STAGEX(PG8_SA(1, 0), cA + kstep, voffA, gA); PG8_STAGEX(PG8_SB(1, 1), cB + hstepB + kstep, voffB, gB);
        PG8_WAIT_V(6); PG8_BAR;
    }
    for (;;) {
        const bool has_next = S.next(ui + 1, nxt);
        const unsigned nA = has_next ? (unsigned)nxt.pm * tstepA : cA, nB = has_next ? (unsigned)nxt.pn * tstepB : cB;
        for (int t = 0; t < nt; t += 2) {
            const bool last = (t == nt - 2);
            const unsigned a1 = cA + (unsigned)(t + 1) * kstep;
            const unsigned a2 = last ? nA : cA + (unsigned)(t + 2) * kstep, b2 = last ? nB : cB + (unsigned)(t + 2) * kstep;
            const unsigned a3 = a2 + kstep, b3 = b2 + kstep;
            if (last && has_next) S.a_ready(nxt);
            if constexpr (SP2) {
            PG8_LDB(B0, 0, 0); PG8_LDB(B1, 0, 1); PG8_SCHED; PG8_LDA(At, 0, 0); PG8_STAGEX(PG8_SA(1, 1), a1 + hstepA, voffA, gA);
            PG8_WAIT_V(8); PG8_WAIT_L(0); PG8_BAR; PG8_MMA(0, 0, At, B0); PG8_MMA(0, 1, At, B1); PG8_BAR; PG8_SCHED;
            PG8_LDA(At, 0, 1); PG8_STAGEX(PG8_SB(0, 0), b2, voffB, gB); PG8_STAGEX(PG8_SB(0, 1), b2 + hstepB, voffB, gB); PG8_STAGEX(PG8_SA(0, 0), a2, voffA, gA);
            PG8_WAIT_V(8); PG8_WAIT_L(0); PG8_BAR; PG8_MMA(1, 0, At, B0); PG8_MMA(1, 1, At, B1); PG8_BAR; PG8_SCHED;
            PG8_LDB(B0, 1, 0); PG8_LDB(B1, 1, 1); PG8_SCHED; PG8_LDA(At, 1, 0); PG8_STAGEX(PG8_SA(0, 1), a2 + hstepA, voffA, gA);
            PG8_WAIT_V(8); PG8_WAIT_L(0); PG8_BAR; PG8_MMA(0, 0, At, B0); PG8_MMA(0, 1, At, B1); PG8_BAR; PG8_SCHED;
            PG8_LDA(At, 1, 1); PG8_STAGEX(PG8_SB(1, 0), b3, voffB, gB); PG8_STAGEX(PG8_SB(1, 1), b3 + hstepB, voffB, gB); PG8_STAGEX(PG8_SA(1, 0), a3, voffA, gA);
            PG8_WAIT_V(8); PG8_WAIT_L(0); PG8_BAR; PG8_MMA(1, 0, At, B0); PG8_MMA(1, 1, At, B1); PG8_BAR; PG8_SCHED;
            } else {
            PG8_LDB(B0, 0, 0); PG8_SCHED; PG8_LDA(At, 0, 0); PG8_STAGEX(PG8_SA(1, 1), a1 + hstepA, voffA, gA);
            PG8_WAIT_L(8); PG8_BAR; PG8_WAIT_L(0); PG8_MMA(0, 0, At, B0); PG8_BAR; PG8_SCHED;
            PG8_LDB(B1, 0, 1); PG8_STAGEX(PG8_SB(0, 0), b2, voffB, gB);
            PG8_BAR; PG8_WAIT_L(0); PG8_MMA(0, 1, At, B1); PG8_BAR;
            PG8_LDA(At, 0, 1); PG8_STAGEX(PG8_SA(0, 0), a2, voffA, gA);
            PG8_BAR; PG8_WAIT_L(0); PG8_MMA(1, 0, At, B0); PG8_BAR; PG8_SCHED;
            PG8_STAGEX(PG8_SB(0, 1), b2 + hstepB, voffB, gB);
            PG8_WAIT_V(6); PG8_BAR; PG8_MMA(1, 1, At, B1); PG8_BAR;
            PG8_LDB(B0, 1, 0); PG8_SCHED; PG8_LDA(At, 1, 0); PG8_STAGEX(PG8_SA(0, 1), a2 + hstepA, voffA, gA);
            PG8_WAIT_L(8); PG8_BAR; PG8_WAIT_L(0); PG8_MMA(0, 0, At, B0); PG8_BAR; PG8_SCHED;
            PG8_LDB(B1, 1, 1); PG8_STAGEX(PG8_SB(1, 0), b3, voffB, gB);
            PG8_BAR; PG8_WAIT_L(0); PG8_MMA(0, 1, At, B1); PG8_BAR;
            PG8_LDA(At, 1, 1); PG8_STAGEX(PG8_SA(1, 0), a3, voffA, gA);
            PG8_BAR; PG8_WAIT_L(0); PG8_MMA(1, 0, At, B0); PG8_BAR; PG8_SCHED;
            PG8_STAGEX(PG8_SB(1, 1), b3 + hstepB, voffB, gB);
            PG8_WAIT_V(6); PG8_BAR; PG8_MMA(1, 1, At, B1); PG8_BAR;
            }
        }
        if constexpr (ALIGN_EPI) { if (wr == 0) PG8_BAR; }
        if constexpr (!Epi::AFTER_DRAIN) { E(acc, cur, wr, wc, fr, fq); S.done(cur); }
        if (!has_next) break;
#pragma unroll
        for (int a = 0; a < 2; ++a)
#pragma unroll
            for (int b = 0; b < 2; ++b)
#pragma unroll
                for (int m = 0; m < 4; ++m)
#pragma unroll
                    for (int n = 0; n < 2; ++n) acc[a][b][m][n] = (f32x4){0.f, 0.f, 0.f, 0.f};
        cur = nxt; cA = nA; cB = nB; ++ui;
        if constexpr (ALIGN_EPI) { if (wr == 1) PG8_BAR; }
    }
    PG8_WAIT_V(0);
    if constexpr (!ALIGN_EPI) { if (wr == 0) PG8_BAR; }
    PG8_BAR;
    if constexpr (Epi::AFTER_DRAIN) { E.fused(acc, cur, wr, wc, fr, fq, lds, wid, lane); S.done(cur); }
#undef PG8_SA
#undef PG8_SB
#undef PG8_STAGEX
#undef PG8_LDA
#undef PG8_LDB
#undef PG8_MMA
#undef PG8_WAIT_V
#undef PG8_WAIT_L
#undef PG8_BAR
#undef PG8_SCHED
}
}

namespace pg8 {
struct EpiIn {
    static constexpr bool PERM = true, AFTER_DRAIN = false;
    unsigned char* ws;
    __device__ __forceinline__ void operator()(const f32x4 (&acc)[2][2][4][2], const Unit& u, int wr, int wc, int fr_in, int fq_in) const {
        int fr = fr_in, fq = fq_in; asm volatile("" : "+v"(fr), "+v"(fq));
        bf16_t* const O = (bf16_t*)(ws + WS_PROJ); float* const DTF = (float*)(ws + WS_DTF); float* const RSS = (float*)(ws + WS_RSS); bf16_t* const KM = (bf16_t*)(ws + WS_KM); const float* const COS = (const float*)(ws + WS_COS); const float* const SIN = (const float*)(ws + WS_SIN);
        const int row0 = u.pm * BM + wr * 64 + fr, col0 = u.pn * BM + wc * 32 + 8 * fq;
        const float sc = (u.pn == 0) ? DA_SCALE : 1.f;
        const bool dtl = (u.pn == 9) && (wc == 1) && (fq == 0);
#pragma unroll
        for (int ai = 0; ai < 2; ++ai)
#pragma unroll
            for (int m = 0; m < 4; ++m) { const int row = row0 + ai * HALF + m * 16; bf16_t* rowp = O + (size_t)row * DINP + col0;
#pragma unroll
                for (int bj = 0; bj < 2; ++bj) { const f32x4 v0 = acc[ai][bj][m][0] * sc, v1 = acc[ai][bj][m][1] * sc;
                    u32x4 w; w.x = cvt_pk_bf16(v0[0], v0[1]); w.y = cvt_pk_bf16(v0[2], v0[3]); w.z = cvt_pk_bf16(v1[0], v1[1]); w.w = cvt_pk_bf16(v1[2], v1[3]);
                    *(u32x4*)(rowp + bj * HALF) = w;
                    if (bj == 1 && dtl) { *(f32x4*)(DTF + (size_t)row * 8) = v0; *(f32x4*)(DTF + (size_t)row * 8 + 4) = v1; } } }
        if (u.pn == 3 || u.pn == 4) {
            const bool isq = (u.pn == 3);
#pragma unroll
            for (int ai = 0; ai < 2; ++ai)
#pragma unroll
                for (int m = 0; m < 4; ++m) { float ss = 0.f;
#pragma unroll
                    for (int n = 0; n < 2; ++n) { const f32x4 a = acc[ai][0][m][n], b = acc[ai][1][m][n];
                        ss += (a[0] * a[0] + a[1] * a[1]) + (a[2] * a[2] + a[3] * a[3]);
                        if (isq) ss += (b[0] * b[0] + b[1] * b[1]) + (b[2] * b[2] + b[3] * b[3]); }
                    ss += __shfl_xor(ss, 16); ss += __shfl_xor(ss, 32);
                    if (fq == 0) RSS[(size_t)(row0 + ai * HALF + m * 16) * 8 + (isq ? 0 : 4) + wc] = ss; }
        }
        if (u.pn == 4 && wc == 0) {
#pragma unroll
            for (int ai = 0; ai < 2; ++ai)
#pragma unroll
                for (int m = 0; m < 4; ++m) { const int row = row0 + ai * HALF + m * 16; const f32x4 a = acc[ai][1][m][0], b = acc[ai][1][m][1];
                    const float* cp = COS + (size_t)row * 16 + 8 * (fq & 1); const float* sp = SIN + (size_t)row * 16 + 8 * (fq & 1);
                    const f32x4 c0 = *(const f32x4*)cp, c1 = *(const f32x4*)(cp + 4), s0 = *(const f32x4*)sp, s1 = *(const f32x4*)(sp + 4);
                    f32x4 oa, ob; const float sg = (fq < 2) ? -1.f : 1.f;
#pragma unroll
                    for (int e = 0; e < 4; ++e) { const float pa = __shfl_xor(a[e], 32), pb = __shfl_xor(b[e], 32); oa[e] = a[e] * c0[e] + sg * pa * s0[e]; ob[e] = b[e] * c1[e] + sg * pb * s1[e]; }
                    u32x4 w; w.x = cvt_pk_bf16(oa[0], oa[1]); w.y = cvt_pk_bf16(oa[2], oa[3]); w.z = cvt_pk_bf16(ob[0], ob[1]); w.w = cvt_pk_bf16(ob[2], ob[3]);
#pragma unroll
                    for (int h = 0; h < 4; ++h) *(u32x4*)(KM + (size_t)row * 384 + h * 96 + 64 + 8 * fq) = w; }
        }
    }
};
struct EpiMla {
    static constexpr bool PERM = true, AFTER_DRAIN = false;
    unsigned char* ws;
    __device__ __forceinline__ void operator()(const f32x4 (&acc)[2][2][4][2], const Unit& u, int wr, int wc, int fr_in, int fq_in) const {
        int fr = fr_in, fq = fq_in; asm volatile("" : "+v"(fr), "+v"(fq));
        const float* const RSS = (const float*)(ws + WS_RSS); const float* const COS = (const float*)(ws + WS_COS); const float* const SIN = (const float*)(ws + WS_SIN);
        bf16_t* const QM = (bf16_t*)(ws + WS_QM); bf16_t* const KM = (bf16_t*)(ws + WS_KM); bf16_t* const VM = (bf16_t*)(ws + WS_VM);
        const int row0 = u.pm * BM + wr * 64 + fr;
#pragma unroll
        for (int bj = 0; bj < 2; ++bj) { const int g32 = u.pn * 8 + bj * 4 + wc;
            if (g32 < 28) {
                const bool isq = g32 < 12; bool rope = false; bf16_t* base; int ld;
                if (isq) { const int hq = g32 / 3, part = g32 - 3 * hq; base = QM + hq * 96 + part * 32 + 8 * fq; ld = 384; rope = (part == 2); }
                else { const int hk = (g32 - 12) >> 2, part = (g32 - 12) & 3; if (part < 2) { base = KM + hk * 96 + part * 32 + 8 * fq; ld = 384; } else { base = VM + hk * 64 + (part - 2) * 32 + 8 * fq; ld = 256; } }
                const float* rsp = RSS + (isq ? 0 : 4); const float rmul = isq ? (1.f / 256.f) : (1.f / 128.f), rnum = isq ? MLA_SCALE : 1.f;
#pragma unroll
                for (int ai = 0; ai < 2; ++ai)
#pragma unroll
                    for (int m = 0; m < 4; ++m) { const int row = row0 + ai * HALF + m * 16;
                        const f32x4 ps = *(const f32x4*)(rsp + (size_t)row * 8);
                        const float scl = rnum / sqrtf(((ps[0] + ps[1]) + (ps[2] + ps[3])) * rmul + 1e-6f);
                        f32x4 a = acc[ai][bj][m][0] * scl, b = acc[ai][bj][m][1] * scl;
                        if (rope) { const float* cp = COS + (size_t)row * 16 + 8 * (fq & 1); const float* sp = SIN + (size_t)row * 16 + 8 * (fq & 1);
                            const f32x4 c0 = *(const f32x4*)cp, c1 = *(const f32x4*)(cp + 4), s0 = *(const f32x4*)sp, s1 = *(const f32x4*)(sp + 4); const float sg = (fq < 2) ? -1.f : 1.f;
#pragma unroll
                            for (int e = 0; e < 4; ++e) { const float pa = __shfl_xor(a[e], 32), pb = __shfl_xor(b[e], 32); a[e] = a[e] * c0[e] + sg * pa * s0[e]; b[e] = b[e] * c1[e] + sg * pb * s1[e]; } }
                        u32x4 w; w.x = cvt_pk_bf16(a[0], a[1]); w.y = cvt_pk_bf16(a[2], a[3]); w.z = cvt_pk_bf16(b[0], b[1]); w.w = cvt_pk_bf16(b[2], b[3]);
                        *(u32x4*)(base + (size_t)row * ld) = w;
                        if (m & 1) asm volatile("" ::: "memory"); }
            } }
    }
};
struct EpiF32 {
    static constexpr bool PERM = false, AFTER_DRAIN = false;
    float* C; int ldc;
    __device__ __forceinline__ void operator()(const f32x4 (&acc)[2][2][4][2], const Unit& u, int wr, int wc, int fr_in, int fq_in) const {
        int fr = fr_in, fq = fq_in; asm volatile("" : "+v"(fr), "+v"(fq));
        const int row0 = u.pm * BM + wr * 64 + fr, col0 = u.pn * BM + wc * 32 + 4 * fq;
#pragma unroll
        for (int ai = 0; ai < 2; ++ai)
#pragma unroll
            for (int m = 0; m < 4; ++m) { float* rowp = C + (size_t)(row0 + ai * HALF + m * 16) * ldc + col0;
#pragma unroll
                for (int bj = 0; bj < 2; ++bj)
#pragma unroll
                    for (int n = 0; n < 2; ++n) *(f32x4*)(rowp + bj * HALF + n * 16) = acc[ai][bj][m][n]; }
    }
};
struct EpiSqRelu {
    static constexpr bool PERM = true, AFTER_DRAIN = false;
    bf16_t* O; int ldc;
    __device__ __forceinline__ void operator()(const f32x4 (&acc)[2][2][4][2], const Unit& u, int wr, int wc, int fr_in, int fq_in) const {
        int fr = fr_in, fq = fq_in; asm volatile("" : "+v"(fr), "+v"(fq));
        const int row0 = u.pm * BM + wr * 64 + fr, col0 = u.pn * BM + wc * 32 + 8 * fq;
#pragma unroll
        for (int ai = 0; ai < 2; ++ai)
#pragma unroll
            for (int m = 0; m < 4; ++m) { bf16_t* rowp = O + (size_t)(row0 + ai * HALF + m * 16) * ldc + col0;
#pragma unroll
                for (int bj = 0; bj < 2; ++bj) { f32x4 v0 = acc[ai][bj][m][0], v1 = acc[ai][bj][m][1];
#pragma unroll
                    for (int e = 0; e < 4; ++e) { const float a = fmaxf(v0[e], 0.f), b = fmaxf(v1[e], 0.f); v0[e] = a * a; v1[e] = b * b; }
                    u32x4 w; w.x = cvt_pk_bf16(v0[0], v0[1]); w.y = cvt_pk_bf16(v0[2], v0[3]); w.z = cvt_pk_bf16(v1[0], v1[1]); w.w = cvt_pk_bf16(v1[2], v1[3]);
                    *(u32x4*)(rowp + bj * HALF) = w; } }
    }
};
}


namespace att {
typedef __attribute__((ext_vector_type(16))) float f32x16;
typedef __attribute__((ext_vector_type(4))) short s16x4;
typedef __attribute__((ext_vector_type(4))) unsigned u32x4;
typedef __attribute__((address_space(3))) const char* lds_cptr;
typedef short v4i16_t __attribute__((ext_vector_type(4)));
typedef float f32x2_t __attribute__((ext_vector_type(2))); typedef __bf16 bf16x2_t __attribute__((ext_vector_type(2)));
constexpr int L_K = 0, SLOTK_MAX = 12288, L_V = 3 * SLOTK_MAX, SLOTV = 8192, L_WS = L_V + 3 * SLOTV, L_OST = L_WS + 8 * 512, L_END = L_OST + 8 * 8192;
static_assert(L_END <= 131072, "attention LDS map");
constexpr float THR = 8.0f;
__device__ __forceinline__ int crow(int r, int hi) { return (r & 3) + 8 * (r >> 2) + 4 * hi; }
__device__ __forceinline__ void glds16(const void* gsrc, unsigned lds_dst) { unsigned keep;
    asm volatile("s_mov_b32 %0, m0\n\ts_mov_b32 m0, %2\n\ts_nop 0\n\tglobal_load_lds_dwordx4 %1, off\n\ts_mov_b32 m0, %0" : "=&s"(keep) : "v"(gsrc), "s"(lds_dst) : "memory"); }
__device__ __forceinline__ unsigned cvtpk(float lo, float hi) { f32x2_t v = {lo, hi}; bf16x2_t b = __builtin_convertvector(v, bf16x2_t); return __builtin_bit_cast(unsigned, b); }
__device__ __forceinline__ s16x4 vtr(lds_cptr p) { return __builtin_bit_cast(s16x4, __builtin_amdgcn_ds_read_tr16_b64_v4i16((__attribute__((address_space(3))) v4i16_t*)p)); }
__device__ __forceinline__ bf16x8 kld(lds_cptr p) { return *(const __attribute__((address_space(3))) bf16x8*)p; }
#define ATT_MFMA(a, b, c) __builtin_amdgcn_mfma_f32_32x32x16_bf16((a), (b), (c), 0, 0, 0)
#define ATT_WAIT_BAR(N) asm volatile("s_waitcnt vmcnt(" #N ") lgkmcnt(0)\n\ts_barrier" ::: "memory")
__device__ __forceinline__ float rowmax(const f32x16& p0, const f32x16& p1) {
    float a = fmaxf(p0[0], p1[0]);
#pragma unroll
    for (int r = 1; r < 16; ++r) a = fmaxf(a, fmaxf(p0[r], p1[r]));
    auto rr = __builtin_amdgcn_permlane32_swap(__float_as_uint(a), __float_as_uint(a), false, false);
    return fmaxf(__uint_as_float(rr[0]), __uint_as_float(rr[1]));
}
__device__ __forceinline__ void softmax_step(f32x16& p0, f32x16& p1, float& m, float& l, f32x16 (&o)[2], volatile __attribute__((address_space(3))) float* fs, int r32, int hi) {
    const float rm = rowmax(p0, p1);
    if (__any(rm - m > THR)) {
        const float mn = fmaxf(m, rm), f = __builtin_amdgcn_exp2f(m - mn);
        l *= f; m = mn;
        if (hi == 0) fs[r32] = f;
        asm volatile("s_waitcnt lgkmcnt(0)" ::: "memory");
#pragma unroll
        for (int r = 0; r < 16; ++r) { const float fr = fs[crow(r, hi)]; o[0][r] *= fr; o[1][r] *= fr; }
    }
    float sum = 0.f;
#pragma unroll
    for (int r = 0; r < 16; ++r) { p0[r] = __builtin_amdgcn_exp2f(p0[r] - m); p1[r] = __builtin_amdgcn_exp2f(p1[r] - m); sum += p0[r] + p1[r]; }
    l += sum;
}
__device__ __forceinline__ bf16x8 pfrag(const f32x16& p, int b) { u32x4 w; w.x = cvtpk(p[b], p[b + 1]); w.y = cvtpk(p[b + 2], p[b + 3]); w.z = cvtpk(p[b + 4], p[b + 5]); w.w = cvtpk(p[b + 6], p[b + 7]); return __builtin_bit_cast(bf16x8, w); }
__device__ __forceinline__ bf16x8 vfrag(lds_cptr vp, int i) { const s16x4 lo = vtr(vp + ((i >> 2) * 4096 + (i & 3) * 1024)), hi = vtr(vp + ((i >> 2) * 4096 + (i & 3) * 1024 + 512));
    return (bf16x8){lo[0], lo[1], lo[2], lo[3], hi[0], hi[1], hi[2], hi[3]}; }
__device__ __forceinline__ void pv(f32x16 (&o)[2], const f32x16& p0, const f32x16& p1, lds_cptr vp) {
    const bf16x8 a0 = pfrag(p0, 0), a1 = pfrag(p0, 8), a2 = pfrag(p1, 0), a3 = pfrag(p1, 8);
#pragma unroll
    for (int dh = 0; dh < 2; ++dh) {
        o[dh] = ATT_MFMA(a0, vfrag(vp, dh * 4 + 0), o[dh]); o[dh] = ATT_MFMA(a1, vfrag(vp, dh * 4 + 1), o[dh]);
        o[dh] = ATT_MFMA(a2, vfrag(vp, dh * 4 + 2), o[dh]); o[dh] = ATT_MFMA(a3, vfrag(vp, dh * 4 + 3), o[dh]); }
}
template <int ND> __device__ __forceinline__ void qk(f32x16& p0, f32x16& p1, lds_cptr kp, int d0b, const bf16x8* qr) {
    f32x16 z = f32x16{};
#pragma unroll
    for (int d = 0; d < ND; ++d) { const bf16x8 k0 = kld(kp + (d0b + d) * 2048), k1 = kld(kp + (d0b + d) * 2048 + 512);
        p0 = ATT_MFMA(k0, qr[d0b + d], d == 0 ? z : p0); p1 = ATT_MFMA(k1, qr[d0b + d], d == 0 ? z : p1); }
}

template <int KIND>
__device__ __forceinline__ void attn_unit(int qb, const bf16_t* Qb, int ldq, const bf16_t* Kb, int ldk, const bf16_t* Vb, int ldv, bf16_t* Yb, float lam, const float* subln_g, float oml, char* shm) {
    constexpr int NQ = KIND == 0 ? 4 : 6, SLOTK = 2 * NQ * 1024;
    int tid_ = threadIdx.x; asm volatile("" : "+v"(tid_));
    const int tid = tid_, lane = tid & 63, r32 = lane & 31, hi = lane >> 5; const int wid = __builtin_amdgcn_readfirstlane(tid >> 6);
    const int q0 = qb * 256, NT = 4 * qb + 4, ntw = 4 * qb + (wid >> 1) + 1;
    const unsigned lds0 = (unsigned)(uintptr_t)shm;
    volatile __attribute__((address_space(3))) float* wsf = (volatile __attribute__((address_space(3))) float*)((lds_cptr)shm + L_WS) + wid * 128;
    const bf16_t* ksrc = Kb + (size_t)lane * ldk + wid * 8;
    const bf16_t* vsrc = Vb + (size_t)(16 * (wid & 3) + (lane >> 2)) * ldv + (wid >> 2) * 32 + (lane & 3) * 8;
    const unsigned kdst = lds0 + L_K + wid * 1024, vdst = lds0 + L_V + wid * 1024;
    const bool k2 = (KIND == 1) && (wid < 4);
#define ATT_DMA(t, slot) do { glds16(ksrc + (size_t)(t) * 64 * ldk, (unsigned)__builtin_amdgcn_readfirstlane(kdst + (slot) * SLOTK)); \
        if (k2) glds16(ksrc + (size_t)(t) * 64 * ldk + 64, (unsigned)__builtin_amdgcn_readfirstlane(kdst + (slot) * SLOTK + 8192)); \
        glds16(vsrc + (size_t)(t) * 64 * ldv, (unsigned)__builtin_amdgcn_readfirstlane(vdst + (slot) * SLOTV)); } while (0)
    const lds_cptr kp0 = (lds_cptr)shm + L_K + hi * 1024 + r32 * 16;
    const lds_cptr vp0 = (lds_cptr)shm + L_V + ((lane >> 4) & 1) * 32 + (lane & 3) * 8 + (4 * hi + ((lane & 15) >> 2)) * 64;
    bf16x8 qr[NQ];
    { const bf16_t* Qw = Qb + (size_t)(q0 + wid * 32 + r32) * ldq + hi * 8;
#pragma unroll
      for (int d = 0; d < NQ; ++d) qr[d] = *(const bf16x8*)(Qw + d * 16); }
    ATT_DMA(0, 0); ATT_DMA(1, 1);
    float m1 = -1e30f, l1 = 0.f, m2 = -1e30f, l2 = 0.f;
    f32x16 o1[2], o2[2]; o1[0] = f32x16{}; o1[1] = f32x16{}; o2[0] = f32x16{}; o2[1] = f32x16{};
    int slot = 0, slot2 = 2;
    for (int t = 0; t < NT; ++t) {
        if (t + 1 < NT) { if (k2) ATT_WAIT_BAR(3); else ATT_WAIT_BAR(2); } else ATT_WAIT_BAR(0);
        if (t + 2 < NT) ATT_DMA(t + 2, slot2);
        if (t < ntw) {
            const lds_cptr kp = kp0 + slot * SLOTK, vp = vp0 + slot * SLOTV;
            f32x16 p0, p1;
            if (KIND == 0) {
                qk<2>(p0, p1, kp, 0, qr); softmax_step(p0, p1, m1, l1, o1, wsf, r32, hi); pv(o1, p0, p1, vp);
                qk<2>(p0, p1, kp, 2, qr); softmax_step(p0, p1, m2, l2, o2, wsf + 32, r32, hi); pv(o2, p0, p1, vp);
            } else {
                qk<6>(p0, p1, kp, 0, qr); softmax_step(p0, p1, m1, l1, o1, wsf, r32, hi); pv(o1, p0, p1, vp);
            }
        }
        slot = (slot == 2) ? 0 : slot + 1; slot2 = (slot2 == 2) ? 0 : slot2 + 1;
    }
#undef ATT_DMA
    { auto rr = __builtin_amdgcn_permlane32_swap(__float_as_uint(l1), __float_as_uint(l1), false, false); l1 = __uint_as_float(rr[0]) + __uint_as_float(rr[1]); }
    if (KIND == 0) { auto rr = __builtin_amdgcn_permlane32_swap(__float_as_uint(l2), __float_as_uint(l2), false, false); l2 = __uint_as_float(rr[0]) + __uint_as_float(rr[1]); }
    if (hi == 0) { wsf[64 + r32] = 1.0f / l1; if (KIND == 0) wsf[96 + r32] = lam / l2; }
    asm volatile("s_waitcnt lgkmcnt(0)" ::: "memory");
    __attribute__((address_space(3))) float* stg = (__attribute__((address_space(3))) float*)((lds_cptr)shm + L_OST) + wid * 2048;
#pragma unroll
    for (int r = 0; r < 16; ++r) { const int orow = crow(r, hi); const float s1 = wsf[64 + orow]; float s2 = 0.f; if (KIND == 0) s2 = wsf[96 + orow];
#pragma unroll
        for (int dh = 0; dh < 2; ++dh) { float v = o1[dh][r] * s1; if (KIND == 0) v -= o2[dh][r] * s2; stg[orow * 64 + dh * 32 + r32] = v; } }
    asm volatile("s_waitcnt lgkmcnt(0)" ::: "memory");
    bf16_t* Yw = Yb + (size_t)(q0 + wid * 32) * DM;
#pragma unroll
    for (int i = 0; i < 4; ++i) { const int row = i * 8 + (lane >> 3), ch = lane & 7;
        f32x4 va = *(const __attribute__((address_space(3))) f32x4*)(stg + row * 64 + ch * 8), vb = *(const __attribute__((address_space(3))) f32x4*)(stg + row * 64 + ch * 8 + 4);
        if (KIND == 0) {
            float ss = va[0] * va[0] + va[1] * va[1] + va[2] * va[2] + va[3] * va[3] + vb[0] * vb[0] + vb[1] * vb[1] + vb[2] * vb[2] + vb[3] * vb[3];
            ss += __shfl_xor(ss, 1); ss += __shfl_xor(ss, 2); ss += __shfl_xor(ss, 4);
            const float rstd = oml / sqrtf(ss * (1.f / 64.f) + 1e-5f);
            const f32x4 ga = *(const f32x4*)(subln_g + ch * 8), gb = *(const f32x4*)(subln_g + ch * 8 + 4);
            va = va * rstd * ga; vb = vb * rstd * gb; }
        u32x4 w; w.x = cvtpk(va[0], va[1]); w.y = cvtpk(va[2], va[3]); w.z = cvtpk(vb[0], vb[1]); w.w = cvtpk(vb[2], vb[3]);
        *(u32x4*)(Yw + (size_t)row * DM + ch * 8) = w; }
    asm volatile("s_waitcnt lgkmcnt(0)\n\ts_barrier" ::: "memory");
}

template <int NL, class F> __device__ __forceinline__ void conv_pair(const bf16_t* xp, int pos0, const float* cw, const float* cb, F emit) {
    float w0[4], w1[4];
#pragma unroll
    for (int w = 0; w < 4; ++w) { w0[w] = cw[w * 768]; w1[w] = cw[w * 768 + 1]; }
    const float b0 = cb[0], b1 = cb[1];
    float x0[3], x1[3];
#pragma unroll
    for (int i = 0; i < 3; ++i) { unsigned u = 0u; if (pos0 - 3 + i >= 0) u = *(const unsigned*)(xp + (ptrdiff_t)(i - 3) * DINP); x0[i] = __uint_as_float(u << 16); x1[i] = __uint_as_float(u & 0xffff0000u); }
#pragma unroll 8
    for (int l = 0; l < NL; ++l) { const unsigned u = *(const unsigned*)(xp + (size_t)l * DINP); const float c0 = __uint_as_float(u << 16), c1 = __uint_as_float(u & 0xffff0000u);
        const float a0 = b0 + w0[0] * x0[0] + w0[1] * x0[1] + w0[2] * x0[2] + w0[3] * c0, a1 = b1 + w1[0] * x1[0] + w1[1] * x1[1] + w1[2] * x1[2] + w1[3] * c1;
        x0[0] = x0[1]; x0[1] = x0[2]; x0[2] = c0; x1[0] = x1[1]; x1[1] = x1[2]; x1[2] = c1;
        emit(l, silu_f(a0), silu_f(a1)); }
}
__device__ __forceinline__ void dt_acs(const float* DTF, int t0, int h, const float* dt_bias, const float* a_log, int lane, float& dt, float& acs) {
    const float r = DTF[(size_t)(t0 + lane) * 8 + h] + dt_bias[h]; dt = r > 20.f ? r : log1pf(__expf(r));
    float cs = dt * (-__expf(a_log[h]));
#pragma unroll
    for (int o = 1; o < 64; o <<= 1) { const float v = __shfl_up(cs, o); if (lane >= o) cs += v; }
    acs = cs;
}
typedef __attribute__((address_space(3))) float* lds_fptr;
typedef __attribute__((address_space(3))) char* lds_ptr;
constexpr int LA_XW = 0, LA_B = 65536, LA_DT = 81920, LA_ACS = 83968, LA_END = 86016;
__device__ __forceinline__ void ssd_a_unit(int unit, unsigned char* ws, const float* conv_w, const float* conv_b, const float* dt_bias, const float* a_log, char* shm) {
    int tid_ = threadIdx.x; asm volatile("" : "+v"(tid_));
    const int tid = tid_, lane = tid & 63, r32 = lane & 31, hi = lane >> 5; const int wid = __builtin_amdgcn_readfirstlane(tid >> 6);
    const int t0 = unit * 64, c = unit & 63;
    const bf16_t* PROJ = (const bf16_t*)(ws + WS_PROJ); const float* DTF = (const float*)(ws + WS_DTF);
    const lds_ptr sh = (lds_ptr)shm; const lds_fptr dts = (lds_fptr)(sh + LA_DT), acl = (lds_fptr)(sh + LA_ACS);
    { float dt, cs; dt_acs(DTF, t0, wid, dt_bias, a_log, lane, dt, cs); dts[wid * 64 + lane] = dt; acl[wid * 64 + lane] = cs;
      if (lane == 63) ((float*)(ws + WS_CDEC))[unit * 8 + wid] = __expf(cs); }
    __syncthreads();
    for (int item = tid; item < 640; item += NWAVES * 64) { const int pair = item % 320, th = item / 320, ch = 2 * pair, l0 = 32 * th;
        const bf16_t* xp = PROJ + (size_t)(t0 + l0) * DINP + C_XBC + ch;
        if (ch < 512) { const int h = ch >> 6, p = ch & 63; const float a63 = acl[h * 64 + 63]; const lds_ptr dst = sh + LA_XW + h * 8192 + (p >> 5) * 4096 + (p & 31) * 2;
            conv_pair<32>(xp, c * 64 + l0, conv_w + ch, conv_b + ch, [&](int l, float v0, float v1) { const float w = dts[h * 64 + l0 + l] * __expf(a63 - acl[h * 64 + l0 + l]);
                *(__attribute__((address_space(3))) unsigned*)(dst + (l0 + l) * 64) = cvtpk(v0 * w, v1 * w); }); }
        else { const int g = (ch - 512) >> 6, n = (ch - 512) & 63; const lds_ptr dst = sh + LA_B + g * 8192 + (n >> 5) * 4096 + (n & 31) * 2;
            conv_pair<32>(xp, c * 64 + l0, conv_w + ch, conv_b + ch, [&](int l, float v0, float v1) { *(__attribute__((address_space(3))) unsigned*)(dst + (l0 + l) * 64) = cvtpk(v0, v1); }); }
    }
    __syncthreads();
    { const int h = wid, g = h >> 2; const int loff = ((lane >> 4) & 1) * 32 + (lane & 3) * 8 + (4 * hi + ((lane & 15) >> 2)) * 64;
      const lds_cptr xw = (lds_cptr)sh + LA_XW + h * 8192 + loff, bi = (lds_cptr)sh + LA_B + g * 8192 + loff;
      f32x16 acc[2][2]; acc[0][0] = f32x16{}; acc[0][1] = f32x16{}; acc[1][0] = f32x16{}; acc[1][1] = f32x16{};
#pragma unroll
      for (int ks = 0; ks < 4; ++ks) { const bf16x8 b0 = vfrag(bi, ks), b1 = vfrag(bi, 4 + ks), x0 = vfrag(xw, ks), x1 = vfrag(xw, 4 + ks);
          acc[0][0] = ATT_MFMA(b0, x0, acc[0][0]); acc[0][1] = ATT_MFMA(b0, x1, acc[0][1]); acc[1][0] = ATT_MFMA(b1, x0, acc[1][0]); acc[1][1] = ATT_MFMA(b1, x1, acc[1][1]); }
      bf16_t* out = (bf16_t*)(ws + WS_CSB) + (size_t)(unit * 8 + h) * 4096;
#pragma unroll
      for (int nb = 0; nb < 2; ++nb)
#pragma unroll
          for (int pb = 0; pb < 2; ++pb)
#pragma unroll
              for (int k = 0; k < 4; ++k) { const f32x16& a = acc[nb][pb]; uint2 w; w.x = cvtpk(a[4 * k], a[4 * k + 1]); w.y = cvtpk(a[4 * k + 2], a[4 * k + 3]);
                  *(uint2*)(out + (size_t)(32 * pb + r32) * 64 + 32 * nb + 8 * k + 4 * hi) = w; } }
    asm volatile("s_waitcnt lgkmcnt(0)" ::: "memory"); __syncthreads();
}
__device__ __forceinline__ void ssd_scan(unsigned char* ws, int bx, int G) {
    int tid_ = threadIdx.x; asm volatile("" : "+v"(tid_));
    const bf16_t* CSB = (const bf16_t*)(ws + WS_CSB); bf16_t* PRVB = (bf16_t*)(ws + WS_PRVB); const float* CDEC = (const float*)(ws + WS_CDEC);
    for (int idx = bx * (NWAVES * 64) + tid_; idx < NB * 8 * 2048; idx += G * NWAVES * 64) { const int e2 = idx & 2047, h = (idx >> 11) & 7, b = idx >> 14;
        float s0 = 0.f, s1 = 0.f;
#pragma unroll 8
        for (int c = 0; c < NCH; ++c) { const int unit = b * NCH + c; const size_t off = (size_t)(unit * 8 + h) * 4096 + 2 * e2;
            const unsigned u = *(const unsigned*)(CSB + off); const float dec = CDEC[unit * 8 + h];
            *(unsigned*)(PRVB + off) = cvtpk(s0, s1);
            s0 = s0 * dec + __uint_as_float(u << 16); s1 = s1 * dec + __uint_as_float(u & 0xffff0000u); } }
}
constexpr int LC_XD = 0, LC_B = 32768, LC_C = 40960, LC_DT = 49152, LC_ACS = 50176, LC_SS = 51200, LC_STG = 65536, LC_END = 131072;
__device__ __forceinline__ void ssd_c_unit(int unit, unsigned char* ws, const float* conv_w, const float* conv_b, const float* dt_bias, const float* a_log, const float* d_skip, const float* norm_g, char* shm) {
    int tid_ = threadIdx.x; asm volatile("" : "+v"(tid_));
    const int tid = tid_, lane = tid & 63, r32 = lane & 31, hi = lane >> 5; const int wid = __builtin_amdgcn_readfirstlane(tid >> 6);
    const int bc = unit >> 1, g = unit & 1, t0 = bc * 64, c = bc & 63;
    const bf16_t* PROJ = (const bf16_t*)(ws + WS_PROJ); const float* DTF = (const float*)(ws + WS_DTF);
    const lds_ptr sh = (lds_ptr)shm; const lds_fptr dts = (lds_fptr)(sh + LC_DT), acl = (lds_fptr)(sh + LC_ACS), ssq = (lds_fptr)(sh + LC_SS);
    if (wid < 4) { float dt, cs; dt_acs(DTF, t0, 4 * g + wid, dt_bias, a_log, lane, dt, cs); dts[wid * 64 + lane] = dt; acl[wid * 64 + lane] = cs; }
    __syncthreads();
    for (int item = tid; item < 768; item += NWAVES * 64) { const int pair = item % 192, tq = item / 192, l0 = 16 * tq;
        if (pair < 128) { const int ch = 256 * g + 2 * pair, hl = pair >> 5, p = (2 * pair) & 63; const lds_ptr dst = sh + LC_XD + hl * 8192 + (p >> 5) * 4096 + (p & 31) * 2;
            conv_pair<16>(PROJ + (size_t)(t0 + l0) * DINP + C_XBC + ch, c * 64 + l0, conv_w + ch, conv_b + ch, [&](int l, float v0, float v1) { const float w = dts[hl * 64 + l0 + l];
                *(__attribute__((address_space(3))) unsigned*)(dst + (l0 + l) * 64) = cvtpk(v0 * w, v1 * w); }); }
        else { const int isc = (pair >= 160), n = 2 * (pair - 128 - 32 * isc), ch = 512 + 128 * isc + 64 * g + n; const lds_ptr dst = sh + (isc ? LC_C : LC_B) + (n >> 3) * 1024 + (n & 7) * 2;
            conv_pair<16>(PROJ + (size_t)(t0 + l0) * DINP + C_XBC + ch, c * 64 + l0, conv_w + ch, conv_b + ch, [&](int l, float v0, float v1) { *(__attribute__((address_space(3))) unsigned*)(dst + (l0 + l) * 16) = cvtpk(v0, v1); }); }
    }
    __syncthreads();
    const int hl = wid & 3, lb = wid >> 2, h = 4 * g + hl;
    f32x16 o[2];
    {
        bf16x8 cq[4];
#pragma unroll
        for (int d = 0; d < 4; ++d) cq[d] = kld((lds_cptr)sh + LC_C + (2 * d + hi) * 1024 + (32 * lb + r32) * 16);
        const bf16_t* pv_ = (const bf16_t*)(ws + WS_PRVB) + (size_t)(bc * 8 + h) * 4096 + (size_t)r32 * 64 + 8 * hi;
        o[0] = f32x16{}; o[1] = f32x16{};
#pragma unroll
        for (int ks = 0; ks < 4; ++ks) { const bf16x8 p0 = *(const bf16x8*)(pv_ + 16 * ks), p1 = *(const bf16x8*)(pv_ + 32 * 64 + 16 * ks);
            o[0] = ATT_MFMA(cq[ks], p0, o[0]); o[1] = ATT_MFMA(cq[ks], p1, o[1]); }
#pragma unroll
        for (int r = 0; r < 16; ++r) { const float e = __expf(acl[hl * 64 + 32 * lb + crow(r, hi)]); o[0][r] *= e; o[1][r] *= e; }
        const int l = 32 * lb + r32; const float acs_l = acl[hl * 64 + l], ddt = d_skip[h] / dts[hl * 64 + l];
        const int loff = ((lane >> 4) & 1) * 32 + (lane & 3) * 8 + (4 * hi + ((lane & 15) >> 2)) * 64; const lds_cptr xd = (lds_cptr)sh + LC_XD + hl * 8192 + loff;
        for (int sb = 0; sb <= lb; ++sb) {
            f32x16 x = f32x16{};
#pragma unroll
            for (int d = 0; d < 4; ++d) x = ATT_MFMA(kld((lds_cptr)sh + LC_B + (2 * d + hi) * 1024 + (32 * sb + r32) * 16), cq[d], x);
#pragma unroll
            for (int r = 0; r < 16; ++r) { const int s_ = 32 * sb + crow(r, hi); float v = (s_ <= l) ? x[r] * __expf(acs_l - acl[hl * 64 + s_]) : 0.f; if (s_ == l) v += ddt; x[r] = v; }
            const bf16x8 a0 = pfrag(x, 0), a1 = pfrag(x, 8);
#pragma unroll
            for (int pb = 0; pb < 2; ++pb) { o[pb] = ATT_MFMA(a0, vfrag(xd, pb * 4 + 2 * sb), o[pb]); o[pb] = ATT_MFMA(a1, vfrag(xd, pb * 4 + 2 * sb + 1), o[pb]); }
        }
    }
    const lds_fptr stg = (lds_fptr)(sh + LC_STG) + wid * 2048;
#pragma unroll
    for (int r = 0; r < 16; ++r) { const int orow = crow(r, hi); stg[orow * 64 + r32] = o[0][r]; stg[orow * 64 + 32 + r32] = o[1][r]; }
    asm volatile("s_waitcnt lgkmcnt(0)" ::: "memory");
    f32x4 ya[4], yb[4];
#pragma unroll
    for (int i = 0; i < 4; ++i) { const int row = i * 8 + (lane >> 3), ch = lane & 7; const int t = t0 + 32 * lb + row;
        ya[i] = *(const __attribute__((address_space(3))) f32x4*)(stg + row * 64 + ch * 8); yb[i] = *(const __attribute__((address_space(3))) f32x4*)(stg + row * 64 + ch * 8 + 4);
        const u32x4 zz = *(const u32x4*)(PROJ + (size_t)t * DINP + C_Z + h * 64 + ch * 8);
        ya[i][0] *= silu_f(__uint_as_float(zz.x << 16)); ya[i][1] *= silu_f(__uint_as_float(zz.x & 0xffff0000u)); ya[i][2] *= silu_f(__uint_as_float(zz.y << 16)); ya[i][3] *= silu_f(__uint_as_float(zz.y & 0xffff0000u));
        yb[i][0] *= silu_f(__uint_as_float(zz.z << 16)); yb[i][1] *= silu_f(__uint_as_float(zz.z & 0xffff0000u)); yb[i][2] *= silu_f(__uint_as_float(zz.w << 16)); yb[i][3] *= silu_f(__uint_as_float(zz.w & 0xffff0000u));
        float ss = (ya[i][0] * ya[i][0] + ya[i][1] * ya[i][1]) + (ya[i][2] * ya[i][2] + ya[i][3] * ya[i][3]) + (yb[i][0] * yb[i][0] + yb[i][1] * yb[i][1]) + (yb[i][2] * yb[i][2] + yb[i][3] * yb[i][3]);
        ss += __shfl_xor(ss, 1); ss += __shfl_xor(ss, 2); ss += __shfl_xor(ss, 4);
        if (ch == 0) ssq[hl * 64 + 32 * lb + row] = ss; }
    __syncthreads();
#pragma unroll
    for (int i = 0; i < 4; ++i) { const int row = i * 8 + (lane >> 3), ch = lane & 7, lt = 32 * lb + row; const int t = t0 + lt;
        const float tot = (ssq[lt] + ssq[64 + lt]) + (ssq[128 + lt] + ssq[192 + lt]); const float rstd = 1.0f / sqrtf(tot * (1.f / 256.f) + 1e-6f);
        const f32x4 ga = *(const f32x4*)(norm_g + h * 64 + ch * 8), gb = *(const f32x4*)(norm_g + h * 64 + ch * 8 + 4);
        const f32x4 va = ya[i] * rstd * ga, vb = yb[i] * rstd * gb;
        u32x4 w; w.x = cvtpk(va[0], va[1]); w.y = cvtpk(va[2], va[3]); w.z = cvtpk(vb[0], vb[1]); w.w = cvtpk(vb[2], vb[3]);
        *(u32x4*)((bf16_t*)(ws + WS_Y) + (size_t)t * DM + 512 + h * 64 + ch * 8) = w; }
    asm volatile("s_waitcnt lgkmcnt(0)" ::: "memory"); __syncthreads();
}
#undef ATT_MFMA
#undef ATT_WAIT_BAR
}

constexpr int RING_OFF = 0, RING_BYTES = 131072;
constexpr int LDSCTL_OFF = RING_BYTES, MISC_OFF = LDSCTL_OFF + 320;
constexpr int LDS_BYTES = 147456;
constexpr int CW_BAR = 4096;
constexpr size_t CTL_ZERO_BYTES = 65536;
#define LAS __attribute__((address_space(3)))
#define GAS __attribute__((address_space(1)))
typedef GAS unsigned gu32;
#define RLX_AGENT __ATOMIC_RELAXED, __HIP_MEMORY_SCOPE_AGENT
constexpr int PH_PRO_A = 0, PH_PRO_B = 1, PH_L0 = 2, PH_PER_LAYER = 9, PH_IN = 0, PH_PREP = 1, PH_SCAN = 2, PH_MIX = 3, PH_OUT = 4, PH_RN1 = 5, PH_UP = 6, PH_DN = 7, PH_RN2 = 8, PH_TOTAL = PH_L0 + DEPTH * PH_PER_LAYER;


struct Args { const void* in[22]; float* out; unsigned char* ws; int ph_lo, ph_hi; };
typedef const __attribute__((address_space(4))) Args* ArgsP;
__device__ __forceinline__ ArgsP kargs() {
#if defined(__HIP_DEVICE_COMPILE__)
    auto p0 = __builtin_amdgcn_kernarg_segment_ptr(); unsigned long long p = (unsigned long long)p0; asm volatile("" : "+s"(p)); return (ArgsP)p;
#else
    return nullptr;
#endif
}
typedef unsigned v4u __attribute__((ext_vector_type(4)));
__device__ __forceinline__ unsigned pk2(float lo, float hi) { return (unsigned)f2bf(lo) | ((unsigned)f2bf(hi) << 16); }
#define LDS_WAIT() asm volatile("s_waitcnt lgkmcnt(0)" ::: "memory")
__device__ __forceinline__ void p0_transpose_item(const float* W, int K, int N, int nblk, bf16_t* WT, LAS float* scr, int item, int lane) {
    const int kb = item / nblk, nb = item % nblk, k0 = 64 * kb, n0 = 32 * nb;
    const bool ok = (n0 + (lane & 31)) < N;
#pragma unroll 8
    for (int i = 0; i < 32; ++i) { const int kk = 2 * i + (lane >> 5); scr[kk * 33 + (lane & 31)] = ok ? W[(size_t)(k0 + kk) * N + n0 + (lane & 31)] : 0.f; }
    LDS_WAIT(); asm volatile("" ::: "memory");
    const int c = lane & 7;
#pragma unroll
    for (int j = 0; j < 4; ++j) { const int n = (lane >> 3) + 8 * j; const LAS float* sp = scr + (8 * c) * 33 + n;
        v4u o; o.x = pk2(sp[0 * 33], sp[1 * 33]); o.y = pk2(sp[2 * 33], sp[3 * 33]); o.z = pk2(sp[4 * 33], sp[5 * 33]); o.w = pk2(sp[6 * 33], sp[7 * 33]);
        *(v4u*)(WT + (size_t)(n0 + n) * K + k0 + 8 * c) = o; }
    LDS_WAIT(); asm volatile("" ::: "memory");
}
__device__ __forceinline__ void row_norm_mod(const float* xrow, const float* g, const float* sh, const float* sc, bf16_t* orow, int lane) {
    const f32x4* xr = (const f32x4*)xrow;
    f32x4 v[4]; float ss = 0.f;
#pragma unroll
    for (int j = 0; j < 4; ++j) { v[j] = xr[lane + 64 * j]; ss += v[j].x * v[j].x + v[j].y * v[j].y + v[j].z * v[j].z + v[j].w * v[j].w; }
    const float rstd = 1.0f / sqrtf(wave_sum(ss) * (1.f / DM) + 1e-6f);
#pragma unroll
    for (int j = 0; j < 4; ++j) { const int col = (lane + 64 * j) * 4;
        const f32x4 gv = *(const f32x4*)(g + col), shv = *(const f32x4*)(sh + col), scv = *(const f32x4*)(sc + col);
        uint2 o; o.x = pk2(v[j].x * rstd * gv.x * (1.f + scv.x) + shv.x, v[j].y * rstd * gv.y * (1.f + scv.y) + shv.y);
        o.y = pk2(v[j].z * rstd * gv.z * (1.f + scv.z) + shv.z, v[j].w * rstd * gv.w * (1.f + scv.w) + shv.w);
        *(uint2*)(orow + col) = o; }
}
__device__ __forceinline__ void prologue_a(ArgsP A, LAS unsigned char* L) {
    unsigned char* ws = A->ws;
    int tid_ = threadIdx.x; asm volatile("" : "+v"(tid_));
    const int tid = tid_, lane = tid & 63, wave = __builtin_amdgcn_readfirstlane(tid >> 6);
    const int G = gridDim.x, gw = blockIdx.x * NWAVES + wave, NGW = G * NWAVES, gt = blockIdx.x * (NWAVES * 64) + tid, NGT = G * NWAVES * 64;
    for (int item = blockIdx.x; item < 2 * 96; item += G) {
        const float* c = (const float*)A->in[1]; const float* w_ada = (const float*)A->in[3]; const float* b_ada = (const float*)A->in[4]; float* MOD = (float*)(ws + WS_MOD);
        LAS float* sc = (LAS float*)L; LAS float* part = (LAS float*)(L + 32768);
        for (int i = tid; i < 8 * 1024; i += NWAVES * 64) sc[i] = silu_f(c[i]);
        __syncthreads();
        const int l = item / 96, n0 = (item % 96) * 64;
        float acc[8];
#pragma unroll
        for (int b = 0; b < 8; ++b) acc[b] = 0.f;
        const float* w = w_ada + ((size_t)l * 1024 + wave * 128) * 6144 + n0 + lane;
#pragma unroll 4
        for (int k = 0; k < 128; ++k) { const float wv = w[(size_t)k * 6144];
#pragma unroll
            for (int b = 0; b < 8; ++b) acc[b] += sc[b * 1024 + wave * 128 + k] * wv; }
#pragma unroll
        for (int b = 0; b < 8; ++b) part[(wave * 8 + b) * 64 + lane] = acc[b];
        __syncthreads();
        { const int b = tid >> 6, col = tid & 63; float sum = 0.f;
#pragma unroll
          for (int w8 = 0; w8 < 8; ++w8) sum += part[(w8 * 8 + b) * 64 + col];
          MOD[(size_t)(l * 8 + b) * 6144 + n0 + col] = sum + b_ada[l * 6144 + n0 + col]; }
        __syncthreads();
    }
    { const int* pos = (const int*)A->in[2]; float* COS = (float*)(ws + WS_COS); float* SIN = (float*)(ws + WS_SIN);
      for (int i = gt; i < T * 16; i += NGT) { const int t = i >> 4, j = i & 15;
          const float inv = (float)pow(10000.0, -(double)j / 16.0); const float ang = (float)pos[t] * inv;
          COS[i] = (float)cos((double)ang); SIN[i] = (float)sin((double)ang); } }
    for (int i = gt; i < DEPTH * 1024 * 384; i += NGT) { const int l = i / (1024 * 384), r = i % (1024 * 384), n = r / 384, k = r % 384; float v = 0.f;
        if (n < 384 && k < 256) v = ((const float*)A->in[9])[l * 256 + k] * ((const float*)A->in[10])[((size_t)l * 256 + k) * 384 + n];
        else if (n >= 384 && n < 896 && k >= 256) v = ((const float*)A->in[11])[l * 128 + (k - 256)] * ((const float*)A->in[12])[((size_t)l * 128 + (k - 256)) * 512 + (n - 384)];
        ((bf16_t*)(ws + WS_W0 + (size_t)l * W_LAYER + W_U))[r] = f2bf(v); }
    LAS float* scr = (LAS float*)(L + wave * 16384);
    constexpr int I_IN = (DM / 64) * (DINP / 32), I_OUT = (DM / 64) * (DM / 32), I_UP = (DM / 64) * (DFF / 32), I_DN = (DFF / 64) * (DM / 32), I_L = I_IN + I_OUT + I_UP + I_DN;
    for (int it = gw; it < DEPTH * I_L; it += NGW) {
        const int l = it / I_L; int r = it % I_L; unsigned char* wl = ws + WS_W0 + (size_t)l * W_LAYER;
        if (r < I_IN) { p0_transpose_item((const float*)A->in[6] + (size_t)l * DM * DIN, DM, DIN, DINP / 32, (bf16_t*)(wl + W_IN), scr, r, lane); continue; } r -= I_IN;
        if (r < I_OUT) { p0_transpose_item((const float*)A->in[19] + (size_t)l * DM * DM, DM, DM, DM / 32, (bf16_t*)(wl + W_OUT), scr, r, lane); continue; } r -= I_OUT;
        if (r < I_UP) { p0_transpose_item((const float*)A->in[20] + (size_t)l * DM * DFF, DM, DFF, DFF / 32, (bf16_t*)(wl + W_UP), scr, r, lane); continue; } r -= I_UP;
        p0_transpose_item((const float*)A->in[21] + (size_t)l * DFF * DM, DFF, DM, DM / 32, (bf16_t*)(wl + W_DN), scr, r, lane);
    }
}
__device__ __forceinline__ void prologue_b(ArgsP A) {
    unsigned char* ws = A->ws;
    int tid_ = threadIdx.x; asm volatile("" : "+v"(tid_));
    const int lane = tid_ & 63, wave = __builtin_amdgcn_readfirstlane(tid_ >> 6), gw = blockIdx.x * NWAVES + wave, NGW = gridDim.x * NWAVES;
    const float* x = (const float*)A->in[0]; const float* g = (const float*)A->in[5]; const float* MOD = (const float*)(ws + WS_MOD);
    for (int row = gw; row < T; row += NGW) { const int b = row / SEQ; row_norm_mod(x + (size_t)row * DM, g, MOD + (size_t)b * 6144, MOD + (size_t)b * 6144 + 1024, (bf16_t*)(ws + WS_XN) + (size_t)row * DM, lane); }
}


#define XB_TMO      128
#define XB_XCNT(j)  (256  + 64 * (j))
#define XB_XSUB(j)  (1280 + 64 * (j))
#define XB_XGEN(j)  (2304 + 64 * (j))
#define XB_TOP      3328
#define XB_TOPGEN   3392
#define XCD_BAR_WORDS 3456
#define XB_SPIN_CAP (1u << 18)

__device__ __forceinline__ unsigned xb_ld(unsigned* p)              { return __hip_atomic_load(p, __ATOMIC_RELAXED, __HIP_MEMORY_SCOPE_AGENT); }
__device__ __forceinline__ unsigned xb_add(unsigned* p, unsigned v) { return __hip_atomic_fetch_add(p, v, __ATOMIC_RELAXED, __HIP_MEMORY_SCOPE_AGENT); }
__device__ __forceinline__ unsigned xb_xcc_id() { return (unsigned)__builtin_amdgcn_s_getreg((3 << 11) | 20) & 0xFu; }
#define XB_SPIN(cond, bar) do { unsigned _sp = 0; while (cond) { __builtin_amdgcn_s_sleep(1); \
    if ((++_sp & 255u) == 0u) { if (xb_ld(&(bar)[XB_TMO])) break; if (_sp > XB_SPIN_CAP) { atomicAdd(&(bar)[XB_TMO], 1u); break; } } } } while (0)

struct XcdBarrier {
    unsigned* bar; unsigned x;
    volatile LAS unsigned* st;
};

__device__ __forceinline__ XcdBarrier xcd_barrier_post(unsigned* bar, volatile LAS unsigned* st) {
    XcdBarrier b; b.bar = bar; b.x = xb_xcc_id(); b.st = st;
    if (threadIdx.x == 0) (void)xb_add(&bar[XB_XCNT(b.x)], 1u);
    return b;
}
__device__ __forceinline__ void xcd_barrier_complete(unsigned* bar, unsigned x, unsigned& nloc, unsigned& nx) {
    const unsigned G = gridDim.x * gridDim.y * gridDim.z;
    unsigned sum, cnt, mine, sp = 0u;
    for (;;) {
        sum = 0u; cnt = 0u; mine = 0u;
#pragma unroll
        for (unsigned j = 0; j < 16; ++j) { const unsigned c = xb_ld(&bar[XB_XCNT(j)]); sum += c; cnt += (c > 0u) ? 1u : 0u; mine = (j == x) ? c : mine; }
        if (sum == G) break;
        __builtin_amdgcn_s_sleep(1);
        if ((++sp & 255u) == 0u) { if (xb_ld(&bar[XB_TMO])) break; if (sp > XB_SPIN_CAP) { atomicAdd(&bar[XB_TMO], 1u); break; } }
    }
    nloc = mine > 0u ? mine : 1u; nx = cnt > 0u ? cnt : 1u;
}

__device__ __forceinline__ void xcd_barrier(const XcdBarrier& b) {
    asm volatile("s_waitcnt vmcnt(0)" ::: "memory");
    __syncthreads();
    if (threadIdx.x == 0) {
        unsigned* bar = b.bar;
        __builtin_amdgcn_s_waitcnt(0);
        unsigned nloc = b.st[0], nx = b.st[1];
        if (nloc == 0u) { xcd_barrier_complete(bar, b.x, nloc, nx); b.st[0] = nloc; b.st[1] = nx; }
        const unsigned old = xb_add(&bar[XB_XSUB(b.x)], 1u);
        const unsigned gen = old / nloc;
        if (old + 1u == (gen + 1u) * nloc) {
            __builtin_amdgcn_fence(__ATOMIC_RELEASE, "agent");
            asm volatile("s_waitcnt vmcnt(0)" ::: "memory");
            const unsigned og = xb_add(&bar[XB_TOP], 1u);
            const unsigned tg = og / nx;
            if (og + 1u == (tg + 1u) * nx) xb_add(&bar[XB_TOPGEN], 1u);
            else XB_SPIN(xb_ld(&bar[XB_TOPGEN]) == tg, bar);
            __builtin_amdgcn_fence(__ATOMIC_ACQUIRE, "agent");
            xb_add(&bar[XB_XGEN(b.x)], 1u);
            asm volatile("s_waitcnt vmcnt(0)" ::: "memory");
        } else {
            XB_SPIN(xb_ld(&bar[XB_XGEN(b.x)]) == gen, bar);
            __builtin_amdgcn_fence(__ATOMIC_ACQUIRE, "agent");
            asm volatile("s_waitcnt vmcnt(0)" ::: "memory");
        }
    }
    __syncthreads();
}

__device__ __forceinline__ void row_resnorm(const float* xi, const float* yo, const float* gw, const float* gate, float* xo, const float* g2, const float* sh, const float* sc, bf16_t* XNrow, int lane) {
    const f32x4* yr = (const f32x4*)yo; const f32x4* xr = (const f32x4*)xi;
    f32x4 v[4]; float ss = 0.f;
#pragma unroll
    for (int j = 0; j < 4; ++j) { v[j] = yr[lane + 64 * j]; ss += v[j].x * v[j].x + v[j].y * v[j].y + v[j].z * v[j].z + v[j].w * v[j].w; }
    const float rstd = 1.0f / sqrtf(wave_sum(ss) * (1.f / DM) + 1e-6f);
    float s2 = 0.f;
#pragma unroll
    for (int j = 0; j < 4; ++j) { const int col = (lane + 64 * j) * 4;
        const f32x4 gv = *(const f32x4*)(gw + col), gt = *(const f32x4*)(gate + col), xv = xr[lane + 64 * j];
        v[j].x = xv.x + gt.x * (v[j].x * rstd * gv.x); v[j].y = xv.y + gt.y * (v[j].y * rstd * gv.y); v[j].z = xv.z + gt.z * (v[j].z * rstd * gv.z); v[j].w = xv.w + gt.w * (v[j].w * rstd * gv.w);
        *(f32x4*)(xo + col) = v[j];
        s2 += v[j].x * v[j].x + v[j].y * v[j].y + v[j].z * v[j].z + v[j].w * v[j].w; }
    if (XNrow) {
        const float r2 = 1.0f / sqrtf(wave_sum(s2) * (1.f / DM) + 1e-6f);
#pragma unroll
        for (int j = 0; j < 4; ++j) { const int col = (lane + 64 * j) * 4;
            const f32x4 gv = *(const f32x4*)(g2 + col), shv = *(const f32x4*)(sh + col), scv = *(const f32x4*)(sc + col);
            uint2 o; o.x = pk2(v[j].x * r2 * gv.x * (1.f + scv.x) + shv.x, v[j].y * r2 * gv.y * (1.f + scv.y) + shv.y);
            o.y = pk2(v[j].z * r2 * gv.z * (1.f + scv.z) + shv.z, v[j].w * r2 * gv.w * (1.f + scv.w) + shv.w);
            *(uint2*)(XNrow + col) = o; }
    }
}
#define SEAM(k) do { if (lo <= (k) && (k) + 1 < hi) xcd_barrier(bar); } while (0)
template <int l> __device__ __forceinline__ void layer_phases(const int lo, const int hi, LAS unsigned char* L, unsigned char* lds, const XcdBarrier& bar) {
        const int base = PH_L0 + l * PH_PER_LAYER;
        if (lo <= base + PH_IN && base + PH_IN < hi) {
            ArgsP A = kargs(); unsigned char* ws = A->ws; unsigned char* wl = ws + WS_W0 + (size_t)l * W_LAYER; (void)wl;
            int bx = blockIdx.x, G = gridDim.x; asm volatile("" : "+s"(bx), "+s"(G));
            pg8::Gemm g{(const bf16_t*)(ws + WS_XN), (const bf16_t*)(wl + W_IN), T, DINP, DM, DM, DM}; pg8::StaticOrder S; S.init(T, DINP, G, bx);
            pg8::EpiIn E{ws};
            pg8::gemm_phase<pg8::EpiIn, pg8::StaticOrder, true, true>(L + RING_OFF, g, S, E);
        }
        SEAM(base + PH_IN);
        if (lo <= base + PH_PREP && base + PH_PREP < hi) {
            ArgsP A = kargs(); unsigned char* ws = A->ws; unsigned char* wl = ws + WS_W0 + (size_t)l * W_LAYER; (void)wl;
            int bx = blockIdx.x, G = gridDim.x; asm volatile("" : "+s"(bx), "+s"(G));
            pg8::Gemm g{(const bf16_t*)(ws + WS_PROJ) + C_CQ, (const bf16_t*)(wl + W_U), T, 1024, 384, DINP, 384}; pg8::StaticOrder S; S.init(T, 1024, G, bx);
            pg8::EpiMla E{ws};
            pg8::gemm_phase<pg8::EpiMla, pg8::StaticOrder, true, true>(L + RING_OFF, g, S, E);
#pragma unroll 1
            for (int unit = bx; unit < NB * NCH; unit += G)
                att::ssd_a_unit(unit, ws, (const float*)A->in[13] + (size_t)l * 4 * 768, (const float*)A->in[14] + l * 768, (const float*)A->in[15] + l * 8, (const float*)A->in[16] + l * 8, (char*)lds + RING_OFF);
        }
        SEAM(base + PH_PREP);
        if (lo <= base + PH_SCAN && base + PH_SCAN < hi) {
            ArgsP A = kargs(); unsigned char* ws = A->ws; unsigned char* wl = ws + WS_W0 + (size_t)l * W_LAYER; (void)wl;
            int bx = blockIdx.x, G = gridDim.x; asm volatile("" : "+s"(bx), "+s"(G));
            att::ssd_scan(ws, bx, G);
        }
        SEAM(base + PH_SCAN);
        if (lo <= base + PH_MIX && base + PH_MIX < hi) {
            ArgsP A = kargs(); unsigned char* ws = A->ws; unsigned char* wl = ws + WS_W0 + (size_t)l * W_LAYER; (void)wl;
            int bx = blockIdx.x, G = gridDim.x; asm volatile("" : "+s"(bx), "+s"(G));
            const int vcu = (G % 8 == 0) ? (bx % 8) * (G / 8) + bx / 8 : bx;
            const int bh = vcu >> 3, sidx = vcu & 7, b = bh >> 2, h = bh & 3;
            const float* lp = (const float*)A->in[7] + l * 128; float ls0 = 0.f, ls1 = 0.f;
            for (int i = 0; i < 32; ++i) { ls0 += lp[i] * lp[32 + i]; ls1 += lp[64 + i] * lp[96 + i]; }
            const float lambda_init = (l == 0) ? 0.2f : (float)(0.8 - 0.6 * 0.7408182206817179);
            const float lam = __expf(ls0) - __expf(ls1) + lambda_init;
            const bf16_t* PROJ = (const bf16_t*)(ws + WS_PROJ) + (size_t)b * SEQ * DINP; bf16_t* Yb = (bf16_t*)(ws + WS_Y) + (size_t)b * SEQ * DM;
            const bf16_t* QMb = (const bf16_t*)(ws + WS_QM) + (size_t)b * SEQ * 384 + h * 96; const bf16_t* KMb = (const bf16_t*)(ws + WS_KM) + (size_t)b * SEQ * 384 + h * 96; const bf16_t* VMb = (const bf16_t*)(ws + WS_VM) + (size_t)b * SEQ * 256 + h * 64;
            const float* sg = (const float*)A->in[8] + l * 64;
            if (bh < 32) {
#pragma unroll 1
                for (int i = 0; i < 2; ++i) { const int qb = i == 0 ? 15 - sidx : sidx;
                    att::attn_unit<0>(qb, PROJ + C_AQ + h * 64, DINP, PROJ + C_AK + h * 64, DINP, PROJ + C_AV + h * 64, DINP, Yb + h * 64, lam, sg, 1.f - lambda_init, (char*)lds + RING_OFF); }
#pragma unroll 1
                for (int i = 0; i < 2; ++i) { const int qb = i == 0 ? 15 - sidx : sidx;
                    att::attn_unit<1>(qb, QMb, 384, KMb, 384, VMb, 256, Yb + 256 + h * 64, 0.f, sg, 1.f, (char*)lds + RING_OFF); }
            }
#pragma unroll 1
            for (int unit = bx; unit < NB * NCH * 2; unit += G)
                att::ssd_c_unit(unit, ws, (const float*)A->in[13] + (size_t)l * 4 * 768, (const float*)A->in[14] + l * 768, (const float*)A->in[15] + l * 8, (const float*)A->in[16] + l * 8, (const float*)A->in[17] + l * 8, (const float*)A->in[18] + l * 512, (char*)lds + RING_OFF);
        }
        SEAM(base + PH_MIX);
        if (lo <= base + PH_OUT && base + PH_OUT < hi) {
            ArgsP A = kargs(); unsigned char* ws = A->ws; unsigned char* wl = ws + WS_W0 + (size_t)l * W_LAYER; (void)wl;
            int bx = blockIdx.x, G = gridDim.x; asm volatile("" : "+s"(bx), "+s"(G));
            pg8::Gemm g{(const bf16_t*)(ws + WS_Y), (const bf16_t*)(wl + W_OUT), T, DM, DM, DM, DM}; pg8::StaticOrder S; S.init(T, DM, G, bx);
            pg8::EpiF32 E{(float*)(ws + WS_YO), DM};
            pg8::gemm_phase<pg8::EpiF32, pg8::StaticOrder, true, true>(L + RING_OFF, g, S, E);
        }
        SEAM(base + PH_OUT);
        if (lo <= base + PH_RN1 && base + PH_RN1 < hi) {
            ArgsP A = kargs(); unsigned char* ws = A->ws; unsigned char* wl = ws + WS_W0 + (size_t)l * W_LAYER; (void)wl;
            int bx = blockIdx.x, G = gridDim.x; asm volatile("" : "+s"(bx), "+s"(G));
            int tid_ = threadIdx.x; asm volatile("" : "+v"(tid_)); const int lane = tid_ & 63, wave = __builtin_amdgcn_readfirstlane(tid_ >> 6);
            const float* xin = (l == 0) ? (const float*)A->in[0] : (const float*)A->out; float* out = A->out; const float* YO = (const float*)(ws + WS_YO); const float* ng = (const float*)A->in[5] + (size_t)l * 4 * DM;
            const float* mod = (const float*)(ws + WS_MOD) + (size_t)l * 8 * 6144;
            for (int row = bx * NWAVES + wave; row < T; row += G * NWAVES) { const float* mb = mod + (size_t)(row / SEQ) * 6144;
                row_resnorm(xin + (size_t)row * DM, YO + (size_t)row * DM, ng + 1 * DM, mb + 2048, out + (size_t)row * DM, ng + 2 * DM, mb + 3072, mb + 4096, (bf16_t*)(ws + WS_XN) + (size_t)row * DM, lane); }
        }
        SEAM(base + PH_RN1);
        if (lo <= base + PH_UP && base + PH_UP < hi) {
            ArgsP A = kargs(); unsigned char* ws = A->ws; unsigned char* wl = ws + WS_W0 + (size_t)l * W_LAYER; (void)wl;
            int bx = blockIdx.x, G = gridDim.x; asm volatile("" : "+s"(bx), "+s"(G));
            pg8::Gemm g{(const bf16_t*)(ws + WS_XN), (const bf16_t*)(wl + W_UP), T, DFF, DM, DM, DM}; pg8::StaticOrder S; S.init(T, DFF, G, bx);
            pg8::EpiSqRelu E{(bf16_t*)(ws + WS_H), DFF};
            pg8::gemm_phase<pg8::EpiSqRelu, pg8::StaticOrder, true, true>(L + RING_OFF, g, S, E);
        }
        SEAM(base + PH_UP);
        if (lo <= base + PH_DN && base + PH_DN < hi) {
            ArgsP A = kargs(); unsigned char* ws = A->ws; unsigned char* wl = ws + WS_W0 + (size_t)l * W_LAYER; (void)wl;
            int bx = blockIdx.x, G = gridDim.x; asm volatile("" : "+s"(bx), "+s"(G));
            pg8::Gemm g{(const bf16_t*)(ws + WS_H), (const bf16_t*)(wl + W_DN), T, DM, DFF, DFF, DFF}; pg8::StaticOrder S; S.init(T, DM, G, bx);
            pg8::EpiF32 E{(float*)(ws + WS_YO), DM};
            pg8::gemm_phase<pg8::EpiF32, pg8::StaticOrder, true, true>(L + RING_OFF, g, S, E);
        }
        SEAM(base + PH_DN);
        if (lo <= base + PH_RN2 && base + PH_RN2 < hi) {
            ArgsP A = kargs(); unsigned char* ws = A->ws; unsigned char* wl = ws + WS_W0 + (size_t)l * W_LAYER; (void)wl;
            int bx = blockIdx.x, G = gridDim.x; asm volatile("" : "+s"(bx), "+s"(G));
            int tid_ = threadIdx.x; asm volatile("" : "+v"(tid_)); const int lane = tid_ & 63, wave = __builtin_amdgcn_readfirstlane(tid_ >> 6);
            float* out = A->out; const float* YO = (const float*)(ws + WS_YO); const float* ng = (const float*)A->in[5] + (size_t)l * 4 * DM;
            const float* mod = (const float*)(ws + WS_MOD) + (size_t)l * 8 * 6144; const float* modn = mod + 8 * 6144;
            for (int row = bx * NWAVES + wave; row < T; row += G * NWAVES) { const float* mb = mod + (size_t)(row / SEQ) * 6144; const float* mn = modn + (size_t)(row / SEQ) * 6144;
                row_resnorm(out + (size_t)row * DM, YO + (size_t)row * DM, ng + 3 * DM, mb + 5120, out + (size_t)row * DM, ng + 4 * DM, mn + 0, mn + 1024, (l + 1 < DEPTH) ? (bf16_t*)(ws + WS_XN) + (size_t)row * DM : (bf16_t*)nullptr, lane); }
        }
        if (l + 1 < DEPTH) SEAM(base + PH_RN2);
}
__global__ void __launch_bounds__(NWAVES * 64, 2) mega(Args args) {
    extern __shared__ __attribute__((aligned(16))) unsigned char lds[];
    LAS unsigned char* L = (LAS unsigned char*)lds;
    const int lo = kargs()->ph_lo, hi = kargs()->ph_hi;
    for (int u = threadIdx.x; u < (LDS_BYTES - LDSCTL_OFF) / 4; u += NWAVES * 64) ((LAS unsigned*)(L + LDSCTL_OFF))[u] = 0u;
    __syncthreads();
    XcdBarrier bar; bar.bar = (unsigned*)(kargs()->ws + WS_CTL) + CW_BAR; bar.x = 0; bar.st = nullptr;
    if (hi - lo > 1) bar = xcd_barrier_post((unsigned*)(kargs()->ws + WS_CTL) + CW_BAR, (volatile LAS unsigned*)(L + MISC_OFF) + 8);
    if (lo <= PH_PRO_A && PH_PRO_A < hi) { prologue_a(kargs(), L); }
    SEAM(PH_PRO_A);
    if (lo <= PH_PRO_B && PH_PRO_B < hi) { prologue_b(kargs()); }
    SEAM(PH_PRO_B);
    layer_phases<0>(lo, hi, L, lds, bar);
    layer_phases<1>(lo, hi, L, lds, bar);
    static_assert(DEPTH == 2, "two layers are instantiated explicitly");
}
static void launch_mega(Args a, int lo, int hi, hipStream_t stream) { a.ph_lo = lo; a.ph_hi = hi; hipLaunchKernelGGL(mega, dim3(256), dim3(NWAVES * 64), LDS_BYTES, stream, a); }
extern "C" void kernel_launch(void* const* d_in, const int* in_sizes, int n_in, void* d_out, int out_size, void* d_ws, size_t ws_size, hipStream_t stream) {
    if (n_in != 22 || out_size != T * DM || ws_size < WS_END) { fprintf(stderr, "kernel_launch: unexpected shapes (n_in %d out %d ws %zu)\n", n_in, out_size, ws_size); return; }
    static int inited = 0;
    if (!inited) { if (hipFuncSetAttribute((const void*)mega, hipFuncAttributeMaxDynamicSharedMemorySize, LDS_BYTES) != hipSuccess) fprintf(stderr, "hipFuncSetAttribute failed\n"); inited = 1; }
    const float* x = (const float*)d_in[0]; const float* c = (const float*)d_in[1]; const int* pos = (const int*)d_in[2];
    const float* w_ada = (const float*)d_in[3]; const float* b_ada = (const float*)d_in[4]; const float* norm_g = (const float*)d_in[5];
    const float* w_in = (const float*)d_in[6]; const float* diff_lambda = (const float*)d_in[7]; const float* subln_g = (const float*)d_in[8];
    const float* q_norm_g = (const float*)d_in[9]; const float* w_uq = (const float*)d_in[10]; const float* kv_norm_g = (const float*)d_in[11]; const float* w_ukv = (const float*)d_in[12];
    const float* conv_w = (const float*)d_in[13]; const float* conv_b = (const float*)d_in[14]; const float* dt_bias = (const float*)d_in[15]; const float* a_log = (const float*)d_in[16];
    const float* d_skip = (const float*)d_in[17]; const float* ssm_norm_g = (const float*)d_in[18]; const float* w_out = (const float*)d_in[19]; const float* w_up = (const float*)d_in[20]; const float* w_down = (const float*)d_in[21];
    char* ws = (char*)d_ws; float* out = (float*)d_out;
    Args a{}; for (int i = 0; i < 22; ++i) a.in[i] = d_in[i]; a.out = out; a.ws = (unsigned char*)d_ws;
    float* MOD = (float*)(ws + WS_MOD); float* COS = (float*)(ws + WS_COS); float* SIN = (float*)(ws + WS_SIN); float* DTF = (float*)(ws + WS_DTF); float* ACS = (float*)(ws + WS_ACS); float* DTV = (float*)(ws + WS_DTV);
    bf16_t* XN = (bf16_t*)(ws + WS_XN); bf16_t* Y = (bf16_t*)(ws + WS_Y); float* YO = (float*)(ws + WS_YO);
    bf16_t* PROJ = (bf16_t*)(ws + WS_PROJ); bf16_t* QM = (bf16_t*)(ws + WS_QM); bf16_t* KM = (bf16_t*)(ws + WS_KM); bf16_t* VM = (bf16_t*)(ws + WS_VM);
    float* XBC = (float*)(ws + WS_XBC); float* CS = (float*)(ws + WS_CS); float* PREV = (float*)(ws + WS_PREV); float* YS = (float*)(ws + WS_YS);
    if (hipMemsetAsync((char*)d_ws + WS_CTL, 0, CTL_ZERO_BYTES, stream) != hipSuccess) { fprintf(stderr, "kernel_launch: memset of the control words failed\n"); return; }
    launch_mega(a, 0, PH_TOTAL, stream);
}
```
